# Optimizing an MI355X kernel written in HIP

```python
import jax, jax.numpy as jnp
from jax import lax
import numpy as np

D_MODEL = 2048
BATCH = 1
SEQ = 8192
DEPTH = 4

GRID_W = 64
N_MEM = 256
EPS = 1e-6
RW_HEADS = 16
RW_HEAD = 64
RW_WIDTH = RW_HEADS * RW_HEAD
W_LORA = 64
A_LORA = 64
V_LORA = 32
G_LORA = 160
RW_GN_EPS = 64e-5
AT_HEADS = 16
AT_KV_HEADS = 4
AT_HEAD = 64
AT_Q = AT_HEADS * AT_HEAD
AT_KV = AT_KV_HEADS * AT_HEAD
Q_BLOCK = 128
ROPE_THETA = 10000.0
X_HEADS = 4
X_HEAD = 128
X_WIDTH = X_HEADS * X_HEAD
D_FF = -(-8 * D_MODEL // (3 * 256)) * 256
RW_COLS = 3 * RW_WIDTH + 2 * W_LORA + 2 * A_LORA + G_LORA
AT_COLS = AT_Q + 2 * AT_KV
GATE_COLS = 2 * D_MODEL
IN_COLS = RW_COLS + AT_COLS + GATE_COLS

kernel_name = "bidir_rwkv7_axial_gqa_hybrid"


def rmsnorm(x, g):
    xf = x.astype(jnp.float32)
    y = xf * lax.rsqrt(jnp.mean(xf * xf, axis=-1, keepdims=True) + EPS)
    return (y * g.astype(jnp.float32)).astype(x.dtype)


def centred_shift(z, mu_prev, mu_next):
    zp = jnp.pad(z, ((0, 0), (1, 0), (0, 0)))[:, :-1]
    zn = jnp.pad(z, ((0, 0), (0, 1), (0, 0)))[:, 1:]
    return z + mu_prev * (zp - z) + mu_next * (zn - z)


def rwkv7_step(state, inp):
    r_t, w_t, k_t, v_t, a_t, b_t = inp
    sa = jnp.einsum('dbhij,dbhj->dbhi', state, a_t)
    state = (state * w_t[..., None, :] + sa[..., :, None] * b_t[..., None, :]
             + v_t[..., :, None] * k_t[..., None, :])
    y = jnp.einsum('dbhij,dbhj->dbhi', state, r_t)
    return state, y


def rwkv7_branch(z, mu_prev, mu_next, w0, w_up, a0, a_up, g_up, k_k, k_a, r_k,
                 ln_w, ln_b, v_first, v_mix):
    B, S, _ = z.shape
    f32 = jnp.float32
    z = centred_shift(z, mu_prev, mu_next)
    o = 0
    r = z[..., o:o + RW_WIDTH]; o += RW_WIDTH
    k = z[..., o:o + RW_WIDTH]; o += RW_WIDTH
    v = z[..., o:o + RW_WIDTH]; o += RW_WIDTH
    wd = z[..., o:o + 2 * W_LORA].reshape(B, S, 2, W_LORA); o += 2 * W_LORA
    ad = z[..., o:o + 2 * A_LORA].reshape(B, S, 2, A_LORA); o += 2 * A_LORA
    gd = z[..., o:o + G_LORA]
    if v_mix is None:
        v_first = v
    else:
        v0, v_down, v_up = v_mix
        v = v + (v_first - v) * jax.nn.sigmoid(v0 + (v @ v_down) @ v_up)
    w_log = -jax.nn.softplus(-(w0 + jnp.einsum('bsdr,drc->bsdc', jnp.tanh(wd), w_up)).astype(f32)) - 0.5
    decay = jnp.exp(-jnp.exp(w_log))
    a = jax.nn.sigmoid((a0 + jnp.einsum('bsdr,drc->bsdc', ad, a_up)).astype(f32))
    g = jax.nn.sigmoid(gd) @ g_up
    kf = k.astype(f32)
    kk = (kf * k_k).reshape(B, S, RW_HEADS, RW_HEAD)
    kk = kk / jnp.maximum(jnp.linalg.norm(kk, axis=-1, keepdims=True), 1e-12)
    kd = kf[:, :, None, :] * (1.0 + (a - 1.0) * k_a)

    hv = lambda t: t.reshape(B, S, 2, RW_HEADS, RW_HEAD)
    two = lambda t: jnp.broadcast_to(t.reshape(B, S, 1, RW_HEADS, RW_HEAD), (B, S, 2, RW_HEADS, RW_HEAD))

    def time_major(t):
        fwd = t[:, :, 0]
        bwd = jnp.flip(t[:, :, 1], axis=1)
        return jnp.transpose(jnp.stack([fwd, bwd], 0), (2, 0, 1, 3, 4))

    rr = two(r.astype(f32))
    vv = two(v.astype(f32))
    kk2 = two(kk)
    kd_h = hv(kd)
    seqs = (time_major(rr), time_major(hv(decay)), time_major(kd_h), time_major(vv),
            time_major(-kk2), time_major(kk2 * hv(a)))
    state0 = jnp.zeros((2, B, RW_HEADS, RW_HEAD, RW_HEAD), f32)
    _, y = lax.scan(rwkv7_step, state0, seqs)
    y = y[:, 0] + jnp.flip(y[:, 1], axis=0)
    y = jnp.transpose(y, (1, 0, 2, 3))
    mu = jnp.mean(y, axis=-1, keepdims=True)
    var = jnp.mean(jnp.square(y - mu), axis=-1, keepdims=True)
    y = ((y - mu) * lax.rsqrt(var + RW_GN_EPS)).reshape(B, S, RW_WIDTH) * ln_w + ln_b
    bonus = jnp.sum(rr * kd_h * r_k, axis=-1, keepdims=True) * vv
    y = y + jnp.sum(bonus, axis=2).reshape(B, S, RW_WIDTH)
    y = y * g
    return y.astype(z.dtype), v_first


def axial_rope(S):
    rows = S // GRID_W
    row = jnp.repeat(jnp.arange(rows), GRID_W)
    col = jnp.tile(jnp.arange(GRID_W), rows)
    n_freq = AT_HEAD // 4
    inv = ROPE_THETA ** (-jnp.arange(n_freq, dtype=jnp.float32) / n_freq)
    ang = jnp.stack([row, col], -1).astype(jnp.float32)[..., None] * inv
    return jnp.cos(ang), jnp.sin(ang)


def apply_rope(t, cos, sin):
    B, S, H, _ = t.shape
    tf = t.astype(jnp.float32).reshape(B, S, H, 2, 2, AT_HEAD // 4)
    t1, t2 = tf[..., 0, :], tf[..., 1, :]
    c = cos[None, :, None]
    s = sin[None, :, None]
    out = jnp.stack([t1 * c - t2 * s, t2 * c + t1 * s], axis=-2)
    return out.reshape(B, S, H, AT_HEAD).astype(t.dtype)


def axial_gqa_branch(z, q_norm, k_norm):
    B, S, _ = z.shape
    q = z[..., :AT_Q].reshape(B, S, AT_HEADS, AT_HEAD)
    k = z[..., AT_Q:AT_Q + AT_KV].reshape(B, S, AT_KV_HEADS, AT_HEAD)
    v = z[..., AT_Q + AT_KV:].reshape(B, S, AT_KV_HEADS, AT_HEAD)
    cos, sin = axial_rope(S)
    q = apply_rope(rmsnorm(q, q_norm), cos, sin)
    k = apply_rope(rmsnorm(k, k_norm), cos, sin)
    G = AT_HEADS // AT_KV_HEADS
    nb = S // Q_BLOCK
    qb = q.reshape(B, nb, Q_BLOCK, AT_KV_HEADS, G, AT_HEAD).transpose(1, 0, 2, 3, 4, 5)
    scale = AT_HEAD ** -0.5

    def block(qi):
        s = jnp.einsum('bqkgd,bskd->bkgqs', qi, k, preferred_element_type=jnp.float32) * scale
        p = jax.nn.softmax(s, axis=-1).astype(v.dtype)
        return jnp.einsum('bkgqs,bskd->bqkgd', p, v)

    o = lax.map(block, qb)
    return o.transpose(1, 0, 2, 3, 4, 5).reshape(B, S, AT_Q)


def memory_cross_attention(h, mem_n, wq, wkv, wo):
    B, S, _ = h.shape
    M = mem_n.shape[1]
    q = (h @ wq).reshape(B, S, X_HEADS, X_HEAD)
    kv = (mem_n @ wkv).reshape(B, M, 2, X_HEADS, X_HEAD)
    s = jnp.einsum('bshd,bmhd->bhsm', q, kv[:, :, 0], preferred_element_type=jnp.float32) * (X_HEAD ** -0.5)
    p = jax.nn.softmax(s, axis=-1).astype(h.dtype)
    o = jnp.einsum('bhsm,bmhd->bshd', p, kv[:, :, 1]).reshape(B, S, X_WIDTH)
    return o @ wo


def swiglu(h, wg, wu, wd):
    return (jax.nn.silu(h @ wg) * (h @ wu)) @ wd


def setup_inputs(seed: int = 0) -> dict:
    key = jax.random.key(seed)
    keys = list(jax.random.split(key, 64))
    idx = [0]

    def nk():
        k = keys[idx[0]]
        idx[0] += 1
        return k

    f32 = jnp.float32
    nrm = lambda shape, scale: jax.random.normal(nk(), shape, f32) * scale
    gain = lambda shape: 1.0 + nrm(shape, 0.02)
    unif = lambda shape, lo, hi: jax.random.uniform(nk(), shape, f32, lo, hi)
    L, D = DEPTH, D_MODEL
    return {
        "x": nrm((BATCH, SEQ, D), 1.0),
        "mem": nrm((BATCH, N_MEM, D), 1.0),
        "n_mix_pre": gain((L, D)),
        "n_mix_post": gain((L, D)),
        "n_x_pre": gain((L, D)),
        "n_x_post": gain((L, D)),
        "n_ffn_pre": gain((L, D)),
        "n_ffn_post": gain((L, D)),
        "n_mem": gain((L, D)),
        "w_in": nrm((L, D, IN_COLS), D ** -0.5),
        "rw_mu_prev": unif((L, RW_COLS), 0.0, 0.5),
        "rw_mu_next": unif((L, RW_COLS), 0.0, 0.5),
        "rw_w0": unif((L, 2, RW_WIDTH), -6.5, -1.5),
        "rw_w_up": nrm((L, 2, W_LORA, RW_WIDTH), 0.1 * W_LORA ** -0.5),
        "rw_a0": nrm((L, 2, RW_WIDTH), 0.1),
        "rw_a_up": nrm((L, 2, A_LORA, RW_WIDTH), 0.1 * A_LORA ** -0.5),
        "rw_g_up": nrm((L, G_LORA, RW_WIDTH), G_LORA ** -0.5),
        "rw_v0": 1.0 + nrm((L - 1, RW_WIDTH), 0.1),
        "rw_v_down": nrm((L - 1, RW_WIDTH, V_LORA), RW_WIDTH ** -0.5),
        "rw_v_up": nrm((L - 1, V_LORA, RW_WIDTH), 0.1 * V_LORA ** -0.5),
        "rw_k_k": 0.85 + nrm((L, RW_WIDTH), 0.02),
        "rw_k_a": 1.0 + nrm((L, RW_WIDTH), 0.02),
        "rw_r_k": nrm((L, RW_HEADS, RW_HEAD), 0.1),
        "rw_ln_w": gain((L, RW_WIDTH)),
        "rw_ln_b": nrm((L, RW_WIDTH), 0.02),
        "w_rw_out": nrm((L, RW_WIDTH, D), RW_WIDTH ** -0.5),
        "at_q_norm": gain((L, AT_HEAD)),
        "at_k_norm": gain((L, AT_HEAD)),
        "w_at_out": nrm((L, AT_Q, D), AT_Q ** -0.5),
        "w_o": nrm((L, D, D), D ** -0.5),
        "x_wq": nrm((L, D, X_WIDTH), D ** -0.5),
        "x_wkv": nrm((L, D, 2 * X_WIDTH), D ** -0.5),
        "x_wo": nrm((L, X_WIDTH, D), X_WIDTH ** -0.5),
        "ffn_wg": nrm((L, D, D_FF), D ** -0.5),
        "ffn_wu": nrm((L, D, D_FF), D ** -0.5),
        "ffn_wd": nrm((L, D_FF, D), D_FF ** -0.5),
    }


def reference(x, mem, n_mix_pre, n_mix_post, n_x_pre, n_x_post, n_ffn_pre, n_ffn_post,
              n_mem, w_in, rw_mu_prev, rw_mu_next, rw_w0, rw_w_up, rw_a0, rw_a_up,
              rw_g_up, rw_v0, rw_v_down, rw_v_up, rw_k_k, rw_k_a, rw_r_k, rw_ln_w,
              rw_ln_b, w_rw_out, at_q_norm, at_k_norm, w_at_out, w_o, x_wq, x_wkv,
              x_wo, ffn_wg, ffn_wu, ffn_wd):
    v_first = None
    for l in range(DEPTH):
        h = rmsnorm(x, n_mix_pre[l])
        z = h @ w_in[l]
        z_rw = z[..., :RW_COLS]
        z_at = z[..., RW_COLS:RW_COLS + AT_COLS]
        z_g = z[..., RW_COLS + AT_COLS:]
        v_mix = None if l == 0 else (rw_v0[l - 1], rw_v_down[l - 1], rw_v_up[l - 1])
        y_rw, v_first = rwkv7_branch(z_rw, rw_mu_prev[l], rw_mu_next[l], rw_w0[l], rw_w_up[l],
                                     rw_a0[l], rw_a_up[l], rw_g_up[l], rw_k_k[l], rw_k_a[l],
                                     rw_r_k[l], rw_ln_w[l], rw_ln_b[l], v_first, v_mix)
        y_at = axial_gqa_branch(z_at, at_q_norm[l], at_k_norm[l])
        gate = jax.nn.sigmoid(z_g.astype(jnp.float32)).astype(x.dtype)
        merged = (gate[..., :D_MODEL] * (y_rw @ w_rw_out[l])
                  + gate[..., D_MODEL:] * (y_at @ w_at_out[l]))
        x = x + rmsnorm(merged @ w_o[l], n_mix_post[l])
        h = rmsnorm(x, n_x_pre[l])
        c = memory_cross_attention(h, rmsnorm(mem, n_mem[l]), x_wq[l], x_wkv[l], x_wo[l])
        x = x + rmsnorm(c, n_x_post[l])
        h = rmsnorm(x, n_ffn_pre[l])
        x = x + rmsnorm(swiglu(h, ffn_wg[l], ffn_wu[l], ffn_wd[l]), n_ffn_post[l])
    return x
```

```cpp
#include <hip/hip_runtime.h>
#include <cstdio>
#include <cstdint>

typedef unsigned short bf16;
typedef short bf16x8 __attribute__((ext_vector_type(8)));
typedef float f32x4 __attribute__((ext_vector_type(4)));

constexpr int S = 8192, D = 2048, NL = 4;
constexpr int RW = 1024, RWC = 3488, ATQ = 1024, ATKV = 256, INC = 9120, ZP = 9216;
constexpr int DFF = 5632, XW = 512, NMEM = 256;
constexpr int COL_R = 0, COL_K = 1024, COL_V = 2048, COL_WD = 3072, COL_AD = 3200, COL_GD = 3328;
constexpr int COL_AQ = 3488, COL_AK = 4512, COL_AV = 4768, COL_G1 = 5024, COL_G2 = 7072;
constexpr float EPS = 1e-6f, GN_EPS = 64e-5f;
constexpr float QSCALE = 0.125f * 1.4426950408889634f;
constexpr float XQSCALE = 0.08838834764831845f * 1.4426950408889634f;

__device__ __forceinline__ unsigned f2bf(float f) { unsigned u = __builtin_bit_cast(unsigned, f); return (u + 0x7fffu + ((u >> 16) & 1u)) >> 16; }
__device__ __forceinline__ float bf2f(unsigned h) { return __builtin_bit_cast(float, h << 16); }
__device__ __forceinline__ float wave_sum(float v) {
#pragma unroll
    for (int o = 1; o < 64; o <<= 1) v += __shfl_xor(v, o);
    return v;
}
__device__ __forceinline__ float wave_max(float v) {
#pragma unroll
    for (int o = 1; o < 64; o <<= 1) v = fmaxf(v, __shfl_xor(v, o));
    return v;
}
__device__ __forceinline__ float sigmoidf_(float x) { return 1.0f / (1.0f + expf(-x)); }

__global__ __launch_bounds__(256) void k_rmsnorm(const float* __restrict__ x, const float* __restrict__ gain, bf16* __restrict__ out, int rows) {
    const int lane = threadIdx.x & 63, row = blockIdx.x * 4 + (threadIdx.x >> 6);
    if (row >= rows) return;
    const f32x4* xr = (const f32x4*)(x + (size_t)row * D) + lane;
    f32x4 v[8]; float ss = 0.f;
#pragma unroll
    for (int j = 0; j < 8; ++j) { v[j] = xr[64 * j]; ss += v[j].x * v[j].x + v[j].y * v[j].y + v[j].z * v[j].z + v[j].w * v[j].w; }
    const float r = rsqrtf(wave_sum(ss) * (1.f / D) + EPS);
    unsigned long long* o8 = (unsigned long long*)(out + (size_t)row * D) + lane;
#pragma unroll
    for (int j = 0; j < 8; ++j) {
        const f32x4 g = ((const f32x4*)gain)[lane + 64 * j];
        const unsigned lo = f2bf(v[j].x * r * g.x) | (f2bf(v[j].y * r * g.y) << 16), hi = f2bf(v[j].z * r * g.z) | (f2bf(v[j].w * r * g.w) << 16);
        o8[64 * j] = (unsigned long long)lo | ((unsigned long long)hi << 32);
    }
}
__global__ __launch_bounds__(256) void k_resnorm(float* __restrict__ x, const float* __restrict__ t, const float* __restrict__ g1, const float* __restrict__ g2, bf16* __restrict__ hb) {
    const int lane = threadIdx.x & 63, row = blockIdx.x * 4 + (threadIdx.x >> 6);
    const f32x4* tr = (const f32x4*)(t + (size_t)row * D) + lane;
    f32x4* xr = (f32x4*)(x + (size_t)row * D) + lane;
    f32x4 v[8]; float ss = 0.f;
#pragma unroll
    for (int j = 0; j < 8; ++j) { v[j] = tr[64 * j]; ss += v[j].x * v[j].x + v[j].y * v[j].y + v[j].z * v[j].z + v[j].w * v[j].w; }
    const float r = rsqrtf(wave_sum(ss) * (1.f / D) + EPS);
    float ss2 = 0.f;
#pragma unroll
    for (int j = 0; j < 8; ++j) {
        const f32x4 g = ((const f32x4*)g1)[lane + 64 * j]; f32x4 xv = xr[64 * j];
        xv.x += v[j].x * r * g.x; xv.y += v[j].y * r * g.y; xv.z += v[j].z * r * g.z; xv.w += v[j].w * r * g.w;
        xr[64 * j] = xv; v[j] = xv; ss2 += xv.x * xv.x + xv.y * xv.y + xv.z * xv.z + xv.w * xv.w;
    }
    if (g2 == nullptr) return;
    const float r2 = rsqrtf(wave_sum(ss2) * (1.f / D) + EPS);
    unsigned long long* o8 = (unsigned long long*)(hb + (size_t)row * D) + lane;
#pragma unroll
    for (int j = 0; j < 8; ++j) {
        const f32x4 g = ((const f32x4*)g2)[lane + 64 * j];
        const unsigned lo = f2bf(v[j].x * r2 * g.x) | (f2bf(v[j].y * r2 * g.y) << 16), hi = f2bf(v[j].z * r2 * g.z) | (f2bf(v[j].w * r2 * g.w) << 16);
        o8[64 * j] = (unsigned long long)lo | ((unsigned long long)hi << 32);
    }
}

enum { EP_BF16 = 0, EP_F32 = 1, EP_GATE1 = 2, EP_GATE2 = 3, EP_SILUMUL = 4 };
struct GemmArgs { const bf16* A; const float* W; void* out; const bf16* Z; const float* tmp; int lda, ldw, M, N, K, ldo, gcol, ldt; float scale; };
template <int EP> __global__ __launch_bounds__(256) void k_gemm(GemmArgs g) {
    __shared__ __attribute__((aligned(16))) bf16 As[64][40];
    __shared__ __attribute__((aligned(16))) bf16 Bs[64][40];
    const int tid = threadIdx.x, lane = tid & 63, wid = tid >> 6, wm = wid >> 1, wn = wid & 1;
    const int m0 = blockIdx.y * 64, n0 = blockIdx.x * 64;
    f32x4 acc[2][2];
#pragma unroll
    for (int a = 0; a < 2; ++a)
#pragma unroll
        for (int b = 0; b < 2; ++b) acc[a][b] = (f32x4){0.f, 0.f, 0.f, 0.f};
    const int arow = tid >> 2, ach = tid & 3;
    const int wk = tid >> 3, wnc = tid & 7;
    const bool wok = (n0 + wnc * 8) < g.N;
    for (int k0 = 0; k0 < g.K; k0 += 32) {
        const uint4 av = *(const uint4*)(g.A + (size_t)(m0 + arow) * g.lda + k0 + ach * 8);
        f32x4 w0 = (f32x4){0.f, 0.f, 0.f, 0.f}, w1 = w0;
        if (wok) { const float* wp = g.W + (size_t)(k0 + wk) * g.ldw + n0 + wnc * 8; w0 = *(const f32x4*)wp; w1 = *(const f32x4*)(wp + 4); }
        __syncthreads();
        *(uint4*)&As[arow][ach * 8] = av;
        Bs[wnc * 8 + 0][wk] = (bf16)f2bf(w0.x); Bs[wnc * 8 + 1][wk] = (bf16)f2bf(w0.y); Bs[wnc * 8 + 2][wk] = (bf16)f2bf(w0.z); Bs[wnc * 8 + 3][wk] = (bf16)f2bf(w0.w);
        Bs[wnc * 8 + 4][wk] = (bf16)f2bf(w1.x); Bs[wnc * 8 + 5][wk] = (bf16)f2bf(w1.y); Bs[wnc * 8 + 6][wk] = (bf16)f2bf(w1.z); Bs[wnc * 8 + 7][wk] = (bf16)f2bf(w1.w);
        __syncthreads();
        bf16x8 af[2], bfr[2];
#pragma unroll
        for (int i = 0; i < 2; ++i) {
            af[i] = *(const bf16x8*)&As[wm * 32 + i * 16 + (lane & 15)][(lane >> 4) * 8];
            bfr[i] = *(const bf16x8*)&Bs[wn * 32 + i * 16 + (lane & 15)][(lane >> 4) * 8];
        }
#pragma unroll
        for (int a = 0; a < 2; ++a)
#pragma unroll
            for (int b = 0; b < 2; ++b) acc[a][b] = __builtin_amdgcn_mfma_f32_16x16x32_bf16(af[a], bfr[b], acc[a][b], 0, 0, 0);
    }
#pragma unroll
    for (int a = 0; a < 2; ++a)
#pragma unroll
        for (int b = 0; b < 2; ++b)
#pragma unroll
            for (int r = 0; r < 4; ++r) {
                const int row = m0 + wm * 32 + a * 16 + 4 * (lane >> 4) + r, col = n0 + wn * 32 + b * 16 + (lane & 15);
                if (col >= g.N) continue;
                const float v = acc[a][b][r];
                if (EP == EP_BF16) ((bf16*)g.out)[(size_t)row * g.ldo + col] = (bf16)f2bf(v * g.scale);
                else if (EP == EP_F32) ((float*)g.out)[(size_t)row * g.ldo + col] = v;
                else if (EP == EP_GATE1) ((float*)g.out)[(size_t)row * g.ldo + col] = sigmoidf_(bf2f(g.Z[(size_t)row * ZP + g.gcol + col])) * v;
                else if (EP == EP_GATE2) ((bf16*)g.out)[(size_t)row * g.ldo + col] = (bf16)f2bf(g.tmp[(size_t)row * g.ldt + col] + sigmoidf_(bf2f(g.Z[(size_t)row * ZP + g.gcol + col])) * v);
                else { const float t = g.tmp[(size_t)row * g.ldt + col]; ((bf16*)g.out)[(size_t)row * g.ldo + col] = (bf16)f2bf(t * sigmoidf_(t) * v); }
            }
}

__global__ void k_rope_table(float* __restrict__ C, float* __restrict__ Sn) {
    const int idx = blockIdx.x * 256 + threadIdx.x; if (idx >= S * 64) return;
    const int t = idx >> 6, j = idx & 63, f = j & 15;
    const float inv = powf(10000.0f, -(float)f / 16.0f);
    const float pos = (j < 32) ? (float)(t >> 6) : (float)(t & 63);
    const float ang = pos * inv;
    C[idx] = cosf(ang); Sn[idx] = sinf(ang);
}

__global__ __launch_bounds__(256) void k_prep_attn(const bf16* __restrict__ Z, const float* __restrict__ qn, const float* __restrict__ kn,
                                                  const float* __restrict__ RC, const float* __restrict__ RS, bf16* __restrict__ QB, bf16* __restrict__ KB, bf16* __restrict__ VB) {
    const int t = blockIdx.x, lane = threadIdx.x & 63, wv = threadIdx.x >> 6;
    const float c = RC[t * 64 + lane], s = RS[t * 64 + lane];
    for (int slot = wv; slot < 24; slot += 4) {
        if (slot >= 20) { const int h = slot - 20; VB[(size_t)t * ATKV + h * 64 + lane] = Z[(size_t)t * ZP + COL_AV + h * 64 + lane]; continue; }
        const bool isq = slot < 16; const int h = isq ? slot : slot - 16;
        const float x = bf2f(Z[(size_t)t * ZP + (isq ? COL_AQ : COL_AK) + h * 64 + lane]);
        const float ss = wave_sum(x * x);
        const float xn = x * rsqrtf(ss * (1.f / 64.f) + EPS) * (isq ? qn[lane] : kn[lane]);
        const float p = __shfl_xor(xn, 16);
        const float o = (lane & 16) ? (xn * c + p * s) : (xn * c - p * s);
        if (isq) QB[(size_t)t * ATQ + h * 64 + lane] = (bf16)f2bf(o * QSCALE);
        else KB[(size_t)t * ATKV + h * 64 + lane] = (bf16)f2bf(o);
    }
}

struct PrepArgs {
    const bf16* Z; const float *mu_p, *mu_n, *w0, *w_up, *a0, *a_up, *g_up, *v0, *v_down, *v_up, *k_k, *k_a, *r_k; const bf16* VFIRST;
    bf16 *R, *V, *KK, *KD0, *KD1, *B0, *B1, *G; float *LW0, *LW1, *BONUS; int layer, pad;
};
__device__ __forceinline__ float zshift(const bf16* __restrict__ Z, const float* __restrict__ mu_p, const float* __restrict__ mu_n, int t, int col) {
    const float z = bf2f(Z[(size_t)t * ZP + col]);
    const float zp = t > 0 ? bf2f(Z[(size_t)(t - 1) * ZP + col]) : 0.f;
    const float zn = t < S - 1 ? bf2f(Z[(size_t)(t + 1) * ZP + col]) : 0.f;
    return z + mu_p[col] * (zp - z) + mu_n[col] * (zn - z);
}
constexpr int PT = 8;
__global__ __launch_bounds__(256) void k_prep_rwkv(PrepArgs p) {
    __shared__ float sm[PT][416];
    __shared__ float vs[PT][1024];
    __shared__ float vdl[PT][32];
    const int tid = threadIdx.x, lane = tid & 63, t0 = blockIdx.x * PT;
    for (int idx = tid; idx < PT * 416; idx += 256) {
        const int tok = idx / 416, c = idx % 416;
        float z = zshift(p.Z, p.mu_p, p.mu_n, t0 + tok, COL_WD + c);
        if (c < 128) z = tanhf(z); else if (c >= 256) z = sigmoidf_(z);
        sm[tok][c] = z;
    }
    for (int idx = tid; idx < PT * 1024; idx += 256) { const int tok = idx >> 10, c = idx & 1023; vs[tok][c] = zshift(p.Z, p.mu_p, p.mu_n, t0 + tok, COL_V + c); }
    __syncthreads();
    if (p.layer > 0) {
        const int tok = tid >> 5, o = tid & 31; float acc = 0.f;
        for (int c = 0; c < 1024; ++c) acc += vs[tok][c] * p.v_down[c * 32 + o];
        vdl[tok][o] = acc;
    }
    __syncthreads();
    for (int i = 0; i < 4; ++i) {
        const int c = tid + 256 * i, head = c >> 6;
        float aw0[PT], aw1[PT], aa0[PT], aa1[PT], ag[PT], avm[PT];
        { const float b0 = p.w0[c], b1 = p.w0[1024 + c], c0 = p.a0[c], c1 = p.a0[1024 + c], d0 = p.layer > 0 ? p.v0[c] : 0.f;
#pragma unroll
          for (int k = 0; k < PT; ++k) { aw0[k] = b0; aw1[k] = b1; aa0[k] = c0; aa1[k] = c1; ag[k] = 0.f; avm[k] = d0; } }
        for (int m = 0; m < 64; ++m) {
            const float u0 = p.w_up[(size_t)m * 1024 + c], u1 = p.w_up[(size_t)(64 + m) * 1024 + c], q0 = p.a_up[(size_t)m * 1024 + c], q1 = p.a_up[(size_t)(64 + m) * 1024 + c];
#pragma unroll
            for (int k = 0; k < PT; ++k) { aw0[k] += sm[k][m] * u0; aw1[k] += sm[k][64 + m] * u1; aa0[k] += sm[k][128 + m] * q0; aa1[k] += sm[k][192 + m] * q1; }
        }
        for (int m = 0; m < 160; ++m) {
            const float gu = p.g_up[(size_t)m * 1024 + c];
#pragma unroll
            for (int k = 0; k < PT; ++k) ag[k] += sm[k][256 + m] * gu;
        }
        if (p.layer > 0)
            for (int o = 0; o < 32; ++o) {
                const float vu = p.v_up[(size_t)o * 1024 + c];
#pragma unroll
                for (int k = 0; k < PT; ++k) avm[k] += vdl[k][o] * vu;
            }
        const float kkw = p.k_k[c], kaw = p.k_a[c], rkw = p.r_k[c];
#pragma unroll
        for (int k = 0; k < PT; ++k) {
            const int t = t0 + k; const size_t o = (size_t)t * 1024 + c;
            const float r = zshift(p.Z, p.mu_p, p.mu_n, t, COL_R + c), kx = zshift(p.Z, p.mu_p, p.mu_n, t, COL_K + c);
            float v = vs[k][c];
            if (p.layer > 0) { const float gate = sigmoidf_(avm[k]); const float vf = bf2f(p.VFIRST[o]); v = v + (vf - v) * gate; }
            const float lw0 = -0.6065306597126334f * sigmoidf_(aw0[k]), lw1 = -0.6065306597126334f * sigmoidf_(aw1[k]);
            const float a_0 = sigmoidf_(aa0[k]), a_1 = sigmoidf_(aa1[k]);
            const float kkr = kx * kkw; const float n2 = wave_sum(kkr * kkr);
            const float kk = kkr / fmaxf(sqrtf(n2), 1e-12f);
            const float kd0 = kx * (1.f + (a_0 - 1.f) * kaw), kd1 = kx * (1.f + (a_1 - 1.f) * kaw);
            const float bon = wave_sum(r * (kd0 + kd1) * rkw);
            p.R[o] = (bf16)f2bf(r); p.V[o] = (bf16)f2bf(v); p.KK[o] = (bf16)f2bf(kk); p.KD0[o] = (bf16)f2bf(kd0); p.KD1[o] = (bf16)f2bf(kd1);
            p.B0[o] = (bf16)f2bf(kk * a_0); p.B1[o] = (bf16)f2bf(kk * a_1); p.G[o] = (bf16)f2bf(ag[k]); p.LW0[o] = lw0; p.LW1[o] = lw1;
            if (lane == 0) p.BONUS[t * 16 + head] = bon;
        }
    }
}

struct ScanArgs { const bf16 *R, *V, *KK, *KD0, *KD1, *B0, *B1; const float *LW0, *LW1; float* YF; };
__global__ __launch_bounds__(64) void k_scan_naive(ScanArgs a) {
    __shared__ float sh[8][5][64];
    const int d = blockIdx.x >> 4, h = blockIdx.x & 15, lane = threadIdx.x;
    const bf16* KD = d ? a.KD1 : a.KD0; const bf16* B = d ? a.B1 : a.B0; const float* LW = d ? a.LW1 : a.LW0;
    float st[64];
#pragma unroll
    for (int j = 0; j < 64; ++j) st[j] = 0.f;
    for (int s0 = 0; s0 < S; s0 += 8) {
        float rv[8], wv[8], kv[8], av[8], bv[8], vv[8];
#pragma unroll
        for (int u = 0; u < 8; ++u) {
            const int step = s0 + u, t = d ? (S - 1 - step) : step; const size_t idx = (size_t)t * 1024 + h * 64 + lane;
            rv[u] = bf2f(a.R[idx]); wv[u] = expf(LW[idx]); kv[u] = bf2f(KD[idx]); av[u] = -bf2f(a.KK[idx]); bv[u] = bf2f(B[idx]); vv[u] = bf2f(a.V[idx]);
        }
        __syncthreads();
#pragma unroll
        for (int u = 0; u < 8; ++u) { sh[u][0][lane] = rv[u]; sh[u][1][lane] = wv[u]; sh[u][2][lane] = kv[u]; sh[u][3][lane] = av[u]; sh[u][4][lane] = bv[u]; }
        __syncthreads();
#pragma unroll
        for (int u = 0; u < 8; ++u) {
            float sa = 0.f;
#pragma unroll
            for (int j = 0; j < 64; ++j) sa += st[j] * sh[u][3][j];
            const float vi = vv[u]; float y = 0.f;
#pragma unroll
            for (int j = 0; j < 64; ++j) { st[j] = st[j] * sh[u][1][j] + sa * sh[u][4][j] + vi * sh[u][2][j]; y += st[j] * sh[u][0][j]; }
            const int step = s0 + u, t = d ? (S - 1 - step) : step;
            a.YF[((size_t)d * S + t) * 1024 + h * 64 + lane] = y;
        }
    }
}

__global__ __launch_bounds__(256) void k_post_rwkv(const float* __restrict__ YF, const bf16* __restrict__ V, const bf16* __restrict__ G, const float* __restrict__ BONUS,
                                                  const float* __restrict__ ln_w, const float* __restrict__ ln_b, bf16* __restrict__ YRW) {
    const int w = blockIdx.x * 4 + (threadIdx.x >> 6), lane = threadIdx.x & 63, t = w >> 4, h = w & 15, c = h * 64 + lane;
    const size_t o = (size_t)t * 1024 + c;
    const float y = YF[o] + YF[(size_t)S * 1024 + o];
    const float mu = wave_sum(y) * (1.f / 64.f); const float dlt = y - mu;
    const float var = wave_sum(dlt * dlt) * (1.f / 64.f);
    float yn = dlt * rsqrtf(var + GN_EPS) * ln_w[c] + ln_b[c];
    yn += BONUS[t * 16 + h] * bf2f(V[o]);
    yn *= bf2f(G[o]);
    YRW[o] = (bf16)f2bf(yn);
}

__global__ __launch_bounds__(256) void k_attn_naive(const bf16* __restrict__ Q, const bf16* __restrict__ K, const bf16* __restrict__ V, bf16* __restrict__ O) {
    __shared__ __attribute__((aligned(16))) float Ks[32][64];
    __shared__ __attribute__((aligned(16))) float Vs[32][64];
    const int tid = threadIdx.x, h = blockIdx.y, kvh = h >> 2, qrow = blockIdx.x * 256 + tid;
    float q[64], o[64];
#pragma unroll
    for (int c = 0; c < 8; ++c) { const uint4 r = *(const uint4*)(Q + (size_t)qrow * ATQ + h * 64 + c * 8); const unsigned w[4] = {r.x, r.y, r.z, r.w};
#pragma unroll
        for (int e = 0; e < 4; ++e) { q[c * 8 + 2 * e] = bf2f(w[e] & 0xffffu); q[c * 8 + 2 * e + 1] = bf2f(w[e] >> 16); } }
#pragma unroll
    for (int j = 0; j < 64; ++j) o[j] = 0.f;
    float m = -1e30f, l = 0.f;
    const int lk = tid >> 3, lc = tid & 7;
    for (int kt = 0; kt < S; kt += 32) {
        __syncthreads();
        { const uint4 r = *(const uint4*)(K + (size_t)(kt + lk) * ATKV + kvh * 64 + lc * 8); const unsigned w[4] = {r.x, r.y, r.z, r.w};
#pragma unroll
          for (int e = 0; e < 4; ++e) { Ks[lk][lc * 8 + 2 * e] = bf2f(w[e] & 0xffffu); Ks[lk][lc * 8 + 2 * e + 1] = bf2f(w[e] >> 16); } }
        { const uint4 r = *(const uint4*)(V + (size_t)(kt + lk) * ATKV + kvh * 64 + lc * 8); const unsigned w[4] = {r.x, r.y, r.z, r.w};
#pragma unroll
          for (int e = 0; e < 4; ++e) { Vs[lk][lc * 8 + 2 * e] = bf2f(w[e] & 0xffffu); Vs[lk][lc * 8 + 2 * e + 1] = bf2f(w[e] >> 16); } }
        __syncthreads();
        float s[32]; float tmax = m;
#pragma unroll
        for (int k = 0; k < 32; ++k) { float acc = 0.f;
#pragma unroll
            for (int j = 0; j < 64; ++j) acc += q[j] * Ks[k][j];
            s[k] = acc; tmax = fmaxf(tmax, acc); }
        const float corr = exp2f(m - tmax); l *= corr; m = tmax;
#pragma unroll
        for (int j = 0; j < 64; ++j) o[j] *= corr;
#pragma unroll
        for (int k = 0; k < 32; ++k) { const float pk = exp2f(s[k] - m); l += pk;
#pragma unroll
            for (int j = 0; j < 64; ++j) o[j] += pk * Vs[k][j]; }
    }
    const float inv = 1.f / l;
#pragma unroll
    for (int j = 0; j < 64; ++j) O[(size_t)qrow * ATQ + h * 64 + j] = (bf16)f2bf(o[j] * inv);
}

__global__ __launch_bounds__(256) void k_xattn_naive(const bf16* __restrict__ XQ, const bf16* __restrict__ MKV, bf16* __restrict__ XO) {
    __shared__ float qs[4][128];
    __shared__ float ps[4][256];
    const int wv = threadIdx.x >> 6, lane = threadIdx.x & 63, w = blockIdx.x * 4 + wv, t = w >> 2, h = w & 3;
    qs[wv][lane] = bf2f(XQ[(size_t)t * XW + h * 128 + lane]); qs[wv][lane + 64] = bf2f(XQ[(size_t)t * XW + h * 128 + 64 + lane]);
    __syncthreads();
    float sc[4]; float mx = -1e30f;
#pragma unroll
    for (int i = 0; i < 4; ++i) { const int key = lane + 64 * i; float acc = 0.f;
        for (int c = 0; c < 16; ++c) { const uint4 r = *(const uint4*)(MKV + (size_t)key * 1024 + h * 128 + c * 8); const unsigned ww[4] = {r.x, r.y, r.z, r.w};
#pragma unroll
            for (int e = 0; e < 4; ++e) { acc += qs[wv][c * 8 + 2 * e] * bf2f(ww[e] & 0xffffu); acc += qs[wv][c * 8 + 2 * e + 1] * bf2f(ww[e] >> 16); } }
        sc[i] = acc; mx = fmaxf(mx, acc); }
    mx = wave_max(mx); float sum = 0.f;
#pragma unroll
    for (int i = 0; i < 4; ++i) { const float pv = exp2f(sc[i] - mx); sum += pv; ps[wv][lane + 64 * i] = pv; }
    sum = wave_sum(sum);
    __syncthreads();
    float o0 = 0.f, o1 = 0.f;
    for (int key = 0; key < 256; ++key) { const float pv = ps[wv][key];
        o0 += pv * bf2f(MKV[(size_t)key * 1024 + 512 + h * 128 + lane]); o1 += pv * bf2f(MKV[(size_t)key * 1024 + 512 + h * 128 + 64 + lane]); }
    const float inv = 1.f / sum;
    XO[(size_t)t * XW + h * 128 + lane] = (bf16)f2bf(o0 * inv); XO[(size_t)t * XW + h * 128 + 64 + lane] = (bf16)f2bf(o1 * inv);
}

constexpr size_t MiB = 1u << 20;
constexpr size_t WS_HB = 1 * MiB, WS_Z = 33 * MiB, WS_RW = 177 * MiB  , WS_LW = 321 * MiB  , WS_BONUS = 385 * MiB,
                 WS_QB = 386 * MiB, WS_KB = 402 * MiB, WS_VB = 406 * MiB, WS_YAT = 410 * MiB, WS_YF = 426 * MiB, WS_YRW = 490 * MiB, WS_MERGED = 506 * MiB,
                 WS_TMP = 538 * MiB, WS_XQ = 602 * MiB, WS_XO = 610 * MiB, WS_MKV = 618 * MiB, WS_MEMN = 620 * MiB, WS_HID = 621 * MiB, WS_TMPH = 709 * MiB,
                 WS_ROPE = 885 * MiB, WS_END = 889 * MiB;

template <int EP> static void gemm(hipStream_t st, const bf16* A, int lda, const float* W, int ldw, int M, int N, int K, void* out, int ldo, float scale = 1.f,
                                   const bf16* Z = nullptr, int gcol = 0, const float* tmp = nullptr, int ldt = 0) {
    GemmArgs g{}; g.A = A; g.W = W; g.out = out; g.Z = Z; g.tmp = tmp; g.lda = lda; g.ldw = ldw; g.M = M; g.N = N; g.K = K; g.ldo = ldo; g.gcol = gcol; g.ldt = ldt; g.scale = scale;
    hipLaunchKernelGGL(k_gemm<EP>, dim3((N + 63) / 64, M / 64), dim3(256), 0, st, g);
}

extern "C" void kernel_launch(void* const* d_in, const int* in_sizes, int n_in, void* d_out, int out_size, void* d_ws, size_t ws_size, hipStream_t stream) {
    if (n_in != 36 || ws_size < WS_END) { fprintf(stderr, "kernel_launch: unexpected n_in %d / ws_size %zu\n", n_in, ws_size); return; }
    const float* const* in = (const float* const*)d_in;
    unsigned char* ws = (unsigned char*)d_ws;
    float* x = (float*)d_out;
    bf16* HB = (bf16*)(ws + WS_HB); bf16* Z = (bf16*)(ws + WS_Z);
    bf16* RWB[9]; for (int i = 0; i < 9; ++i) RWB[i] = (bf16*)(ws + WS_RW + (size_t)i * 16 * MiB);
    bf16 *R = RWB[0], *Vv = RWB[1], *KK = RWB[2], *KD0 = RWB[3], *KD1 = RWB[4], *B0 = RWB[5], *B1 = RWB[6], *G = RWB[7], *VFIRST = RWB[8];
    float* LW0 = (float*)(ws + WS_LW); float* LW1 = (float*)(ws + WS_LW + 32 * MiB); float* BONUS = (float*)(ws + WS_BONUS);
    bf16* QB = (bf16*)(ws + WS_QB); bf16* KB = (bf16*)(ws + WS_KB); bf16* VB = (bf16*)(ws + WS_VB); bf16* YAT = (bf16*)(ws + WS_YAT);
    float* YF = (float*)(ws + WS_YF); bf16* YRW = (bf16*)(ws + WS_YRW); bf16* MERGED = (bf16*)(ws + WS_MERGED); float* TMP = (float*)(ws + WS_TMP);
    bf16* XQ = (bf16*)(ws + WS_XQ); bf16* XO = (bf16*)(ws + WS_XO); bf16* MKV = (bf16*)(ws + WS_MKV); bf16* MEMN = (bf16*)(ws + WS_MEMN);
    bf16* HID = (bf16*)(ws + WS_HID); float* TMPH = (float*)(ws + WS_TMPH); float* RC = (float*)(ws + WS_ROPE); float* RS = (float*)(ws + WS_ROPE + 2 * MiB);

    hipMemcpyAsync(x, in[0], (size_t)S * D * 4, hipMemcpyDeviceToDevice, stream);
    hipLaunchKernelGGL(k_rope_table, dim3(S * 64 / 256), dim3(256), 0, stream, RC, RS);
    hipLaunchKernelGGL(k_rmsnorm, dim3(S / 4), dim3(256), 0, stream, in[0], in[2], HB, S);
    for (int l = 0; l < NL; ++l) {
        hipLaunchKernelGGL(k_rmsnorm, dim3(NMEM / 4), dim3(256), 0, stream, in[1], in[8] + (size_t)l * D, MEMN, NMEM);
        gemm<EP_BF16>(stream, MEMN, D, in[31] + (size_t)l * D * 1024, 1024, NMEM, 1024, D, MKV, 1024);
        gemm<EP_BF16>(stream, HB, D, in[9] + (size_t)l * D * INC, INC, S, INC, D, Z, ZP);
        hipLaunchKernelGGL(k_prep_attn, dim3(S), dim3(256), 0, stream, Z, in[26] + l * 64, in[27] + l * 64, RC, RS, QB, KB, VB);
        PrepArgs p{}; p.Z = Z; p.mu_p = in[10] + (size_t)l * RWC; p.mu_n = in[11] + (size_t)l * RWC; p.w0 = in[12] + (size_t)l * 2048; p.w_up = in[13] + (size_t)l * 2 * 64 * 1024;
        p.a0 = in[14] + (size_t)l * 2048; p.a_up = in[15] + (size_t)l * 2 * 64 * 1024; p.g_up = in[16] + (size_t)l * 160 * 1024;
        p.v0 = l > 0 ? in[17] + (size_t)(l - 1) * 1024 : nullptr; p.v_down = l > 0 ? in[18] + (size_t)(l - 1) * 1024 * 32 : nullptr; p.v_up = l > 0 ? in[19] + (size_t)(l - 1) * 32 * 1024 : nullptr;
        p.k_k = in[20] + (size_t)l * 1024; p.k_a = in[21] + (size_t)l * 1024; p.r_k = in[22] + (size_t)l * 1024; p.VFIRST = VFIRST;
        bf16* Vcur = (l == 0) ? VFIRST : Vv;
        p.R = R; p.V = Vcur; p.KK = KK; p.KD0 = KD0; p.KD1 = KD1; p.B0 = B0; p.B1 = B1; p.G = G; p.LW0 = LW0; p.LW1 = LW1; p.BONUS = BONUS; p.layer = l;
        hipLaunchKernelGGL(k_prep_rwkv, dim3(S / PT), dim3(256), 0, stream, p);
        ScanArgs sa{R, Vcur, KK, KD0, KD1, B0, B1, LW0, LW1, YF};
        hipLaunchKernelGGL(k_scan_naive, dim3(32), dim3(64), 0, stream, sa);
        hipLaunchKernelGGL(k_post_rwkv, dim3(S * 16 / 4), dim3(256), 0, stream, YF, Vcur, G, BONUS, in[23] + (size_t)l * 1024, in[24] + (size_t)l * 1024, YRW);
        hipLaunchKernelGGL(k_attn_naive, dim3(S / 256, 16), dim3(256), 0, stream, QB, KB, VB, YAT);
        gemm<EP_GATE1>(stream, YRW, 1024, in[25] + (size_t)l * 1024 * D, D, S, D, 1024, TMP, D, 1.f, Z, COL_G1);
        gemm<EP_GATE2>(stream, YAT, 1024, in[28] + (size_t)l * 1024 * D, D, S, D, 1024, MERGED, D, 1.f, Z, COL_G2, TMP, D);
        gemm<EP_F32>(stream, MERGED, D, in[29] + (size_t)l * D * D, D, S, D, D, TMP, D);
        hipLaunchKernelGGL(k_resnorm, dim3(S / 4), dim3(256), 0, stream, x, TMP, in[3] + (size_t)l * D, in[4] + (size_t)l * D, HB);
        gemm<EP_BF16>(stream, HB, D, in[30] + (size_t)l * D * XW, XW, S, XW, D, XQ, XW, XQSCALE);
        hipLaunchKernelGGL(k_xattn_naive, dim3(S * 4 / 4), dim3(256), 0, stream, XQ, MKV, XO);
        gemm<EP_F32>(stream, XO, XW, in[32] + (size_t)l * XW * D, D, S, D, XW, TMP, D);
        hipLaunchKernelGGL(k_resnorm, dim3(S / 4), dim3(256), 0, stream, x, TMP, in[5] + (size_t)l * D, in[6] + (size_t)l * D, HB);
        gemm<EP_F32>(stream, HB, D, in[33] + (size_t)l * D * DFF, DFF, S, DFF, D, TMPH, DFF);
        gemm<EP_SILUMUL>(stream, HB, D, in[34] + (size_t)l * D * DFF, DFF, S, DFF, D, HID, DFF, 1.f, nullptr, 0, TMPH, DFF);
        gemm<EP_F32>(stream, HID, DFF, in[35] + (size_t)l * DFF * D, D, S, D, DFF, TMP, D);
        hipLaunchKernelGGL(k_resnorm, dim3(S / 4), dim3(256), 0, stream, x, TMP, in[7] + (size_t)l * D, (l + 1 < NL) ? in[2] + (size_t)(l + 1) * D : (const float*)nullptr, HB);
    }
}
```

```cpp
#include <hip/hip_runtime.h>
#include <cstdio>
#include <cstdint>

typedef unsigned short bf16;
typedef short bf16x8 __attribute__((ext_vector_type(8)));
typedef float f32x4 __attribute__((ext_vector_type(4)));
typedef unsigned v4u __attribute__((ext_vector_type(4)));
#define GAS __attribute__((address_space(1)))
#define LAS __attribute__((address_space(3)))

constexpr int S = 8192, D = 2048, NL = 4;
constexpr int RW = 1024, RWC = 3488, ATQ = 1024, ATKV = 256, INC = 9120, ZP = 9216;
constexpr int DFF = 5632, XW = 512, NMEM = 256;
constexpr int COL_R = 0, COL_K = 1024, COL_V = 2048, COL_WD = 3072, COL_AD = 3200, COL_GD = 3328;
constexpr int COL_AQ = 3488, COL_AK = 4512, COL_AV = 4768, COL_G1 = 5024, COL_G2 = 7072;
constexpr float EPS = 1e-6f, GN_EPS = 64e-5f;
constexpr float QSCALE = 0.125f * 1.4426950408889634f;
constexpr float XQSCALE = 0.08838834764831845f * 1.4426950408889634f;

__device__ __forceinline__ unsigned f2bf(float f) { unsigned u = __builtin_bit_cast(unsigned, f); return (u + 0x7fffu + ((u >> 16) & 1u)) >> 16; }
__device__ __forceinline__ unsigned pk2(float lo, float hi) { return f2bf(lo) | (f2bf(hi) << 16); }
__device__ __forceinline__ float bf2f(unsigned h) { return __builtin_bit_cast(float, h << 16); }
__device__ __forceinline__ int lane_id() { return (int)__builtin_amdgcn_mbcnt_hi(~0u, __builtin_amdgcn_mbcnt_lo(~0u, 0u)); }
__device__ __forceinline__ float shfl_xor_l(float v, int l, int o) { return __builtin_bit_cast(float, __builtin_amdgcn_ds_bpermute((l ^ o) << 2, __builtin_bit_cast(int, v))); }
__device__ __forceinline__ float wave_sum(float v) {
    int l = lane_id(); asm volatile("" : "+v"(l));
#pragma unroll
    for (int o = 1; o < 64; o <<= 1) v += shfl_xor_l(v, l, o);
    return v;
}
__device__ __forceinline__ float sigmoidf_(float x) { return 1.0f / (1.0f + expf(-x)); }

__device__ __forceinline__ float wave_max(float v) {
    int l = lane_id(); asm volatile("" : "+v"(l));
#pragma unroll
    for (int o = 1; o < 64; o <<= 1) v = fmaxf(v, shfl_xor_l(v, l, o));
    return v;
}
__device__ __forceinline__ void ph_norm(int gw, int NGW, int lane, float* x, const float* t, const float* g1, const float* g2, bf16* hb) {
    asm volatile("" : "+v"(lane), "+s"(gw));
    for (int row = gw; row < S; row += NGW) {
        const f32x4* tr = (const f32x4*)(t + (size_t)row * D) + lane; f32x4* xr = (f32x4*)(x + (size_t)row * D) + lane;
        f32x4 v[8]; float ss = 0.f;
#pragma unroll
        for (int j = 0; j < 8; ++j) { v[j] = tr[64 * j]; ss += (v[j].x * v[j].x + v[j].y * v[j].y) + (v[j].z * v[j].z + v[j].w * v[j].w); }
        const float r = rsqrtf(wave_sum(ss) * (1.f / D) + EPS); float ss2 = 0.f;
#pragma unroll
        for (int j = 0; j < 8; ++j) { const f32x4 g = ((const f32x4*)g1)[lane + 64 * j]; f32x4 xv = xr[64 * j];
            xv.x += v[j].x * r * g.x; xv.y += v[j].y * r * g.y; xv.z += v[j].z * r * g.z; xv.w += v[j].w * r * g.w;
            xr[64 * j] = xv; v[j] = xv; ss2 += (xv.x * xv.x + xv.y * xv.y) + (xv.z * xv.z + xv.w * xv.w); }
        if (g2 != nullptr) {
            const float r2 = rsqrtf(wave_sum(ss2) * (1.f / D) + EPS);
            unsigned long long* o8 = (unsigned long long*)(hb + (size_t)row * D) + lane;
#pragma unroll
            for (int j = 0; j < 8; ++j) { const f32x4 g = ((const f32x4*)g2)[lane + 64 * j];
                o8[64 * j] = (unsigned long long)pk2(v[j].x * r2 * g.x, v[j].y * r2 * g.y) | ((unsigned long long)pk2(v[j].z * r2 * g.z, v[j].w * r2 * g.w) << 32); }
        }
    }
}
__device__ __forceinline__ void ph_prep_attn(int gw, int NGW, int lane, const bf16* Z, const float* qn, const float* kn, const float* RC, const float* RS, bf16* QB, bf16* KB, bf16* VB) {
    asm volatile("" : "+v"(lane), "+s"(gw));
    const float qw = qn[lane], kw = kn[lane];
    for (int it = gw; it < S * 24; it += NGW) {
        const int t = it / 24, slot = it % 24;
        if (slot >= 20) { const int h = slot - 20; VB[(size_t)t * ATKV + h * 64 + lane] = Z[(size_t)t * ZP + COL_AV + h * 64 + lane]; continue; }
        const bool isq = slot < 16; const int h = isq ? slot : slot - 16;
        const float c = RC[t * 64 + lane], s = RS[t * 64 + lane];
        const float x = bf2f(Z[(size_t)t * ZP + (isq ? COL_AQ : COL_AK) + h * 64 + lane]);
        const float ss = wave_sum(x * x);
        const float xn = x * rsqrtf(ss * (1.f / 64.f) + EPS) * (isq ? qw : kw);
        const float p = shfl_xor_l(xn, lane, 16);
        const float o = (lane & 16) ? (xn * c + p * s) : (xn * c - p * s);
        if (isq) QB[(size_t)t * ATQ + h * 64 + lane] = (bf16)f2bf(o * QSCALE);
        else KB[(size_t)t * ATKV + h * 64 + lane] = (bf16)f2bf(o);
    }
}
__device__ __forceinline__ void ph_post(int gw, int NGW, int lane, const float* YF, const bf16* V, const bf16* G, const float* BONUS, const float* ln_w, const float* ln_b, bf16* YCAT) {
    asm volatile("" : "+v"(lane), "+s"(gw));
    for (int it = gw; it < S * 16; it += NGW) {
        const int t = it >> 4, h = it & 15, c = h * 64 + lane; const size_t o = (size_t)t * 1024 + c;
        const float y = YF[o] + YF[(size_t)S * 1024 + o];
        const float mu = wave_sum(y) * (1.f / 64.f); const float dlt = y - mu;
        const float var = wave_sum(dlt * dlt) * (1.f / 64.f);
        float yn = dlt * rsqrtf(var + GN_EPS) * ln_w[c] + ln_b[c];
        yn += BONUS[t * 16 + h] * bf2f(V[o]); yn *= bf2f(G[o]);
        YCAT[(size_t)t * 2048 + c] = (bf16)f2bf(yn);
    }
}
__device__ __forceinline__ void ph_xattn(int gw, int NGW, int lane, LAS float* scr, const bf16* XQ, const bf16* MKV, int mp, bf16* XO) {
    asm volatile("" : "+v"(lane), "+s"(gw));
    LAS float* qs = scr; LAS float* ps = scr + 128;
    for (int it = gw; it < S * 4; it += NGW) {
        const int t = it >> 2, h = it & 3;
        qs[lane] = bf2f(XQ[(size_t)t * XW + h * 128 + lane]); qs[lane + 64] = bf2f(XQ[(size_t)t * XW + h * 128 + 64 + lane]);
        asm volatile("s_waitcnt lgkmcnt(0)" ::: "memory");
        float sc[4]; float mx = -1e30f;
#pragma unroll
        for (int i = 0; i < 4; ++i) { const int key = lane + 64 * i; float acc = 0.f;
            for (int c = 0; c < 16; ++c) { const uint4 r = *(const uint4*)(MKV + (size_t)key * mp + h * 128 + c * 8); const unsigned ww[4] = {r.x, r.y, r.z, r.w};
#pragma unroll
                for (int e = 0; e < 4; ++e) { acc += qs[c * 8 + 2 * e] * bf2f(ww[e] & 0xffffu); acc += qs[c * 8 + 2 * e + 1] * bf2f(ww[e] >> 16); } }
            sc[i] = acc; mx = fmaxf(mx, acc); }
        mx = wave_max(mx); float sum = 0.f;
#pragma unroll
        for (int i = 0; i < 4; ++i) { const float pv = exp2f(sc[i] - mx); sum += pv; ps[lane + 64 * i] = pv; }
        sum = wave_sum(sum);
        asm volatile("s_waitcnt lgkmcnt(0)" ::: "memory");
        float o0 = 0.f, o1 = 0.f;
        for (int key = 0; key < 256; ++key) { const float pv = ps[key];
            o0 += pv * bf2f(MKV[(size_t)key * mp + 512 + h * 128 + lane]); o1 += pv * bf2f(MKV[(size_t)key * mp + 512 + h * 128 + 64 + lane]); }
        const float inv = 1.f / sum;
        XO[(size_t)t * XW + h * 128 + lane] = (bf16)f2bf(o0 * inv); XO[(size_t)t * XW + h * 128 + 64 + lane] = (bf16)f2bf(o1 * inv);
        asm volatile("s_waitcnt lgkmcnt(0)" ::: "memory");
    }
}
struct PrepArgs {
    const bf16* Z; const float *mu_p, *mu_n, *w0, *w_up, *a0, *a_up, *g_up, *v0, *v_down, *v_up, *k_k, *k_a, *r_k; const bf16* VFIRST;
    bf16 *R, *V, *KK, *KD0, *KD1, *B0, *B1, *G; float *LW0, *LW1, *BONUS; int layer;
};
__device__ __forceinline__ float zshift(const bf16* Z, const float* mu_p, const float* mu_n, int t, int col) {
    const float z = bf2f(Z[(size_t)t * ZP + col]);
    const float zp = t > 0 ? bf2f(Z[(size_t)(t - 1) * ZP + col]) : 0.f;
    const float zn = t < S - 1 ? bf2f(Z[(size_t)(t + 1) * ZP + col]) : 0.f;
    return z + mu_p[col] * (zp - z) + mu_n[col] * (zn - z);
}
constexpr int PT = 8;
__device__ __forceinline__ void ph_prep_rwkv(LAS unsigned char* lds, const PrepArgs& p, int vcu, int G, int wv) {
    int lane_l = lane_id(); asm volatile("" : "+v"(lane_l), "+s"(wv), "+s"(vcu));
    const int lane = lane_l, tid = __builtin_amdgcn_readfirstlane(wv) * 64 + lane;
    LAS float* sm = (LAS float*)lds;
    LAS float* vs = sm + PT * 416;
    LAS float* vdl = vs + PT * 1024;
    for (int tile = vcu; tile < S / PT; tile += G) {
        const int t0 = tile * PT;
        for (int idx = tid; idx < PT * 416; idx += 512) { const int tok = idx / 416, c = idx % 416;
            float z = zshift(p.Z, p.mu_p, p.mu_n, t0 + tok, COL_WD + c);
            if (c < 128) z = tanhf(z); else if (c >= 256) z = sigmoidf_(z);
            sm[tok * 416 + c] = z; }
        for (int idx = tid; idx < PT * 1024; idx += 512) { const int tok = idx >> 10, c = idx & 1023; vs[tok * 1024 + c] = zshift(p.Z, p.mu_p, p.mu_n, t0 + tok, COL_V + c); }
        __syncthreads();
        if (p.layer > 0 && tid < 256) { const int tok = tid >> 5, o = tid & 31; float acc = 0.f;
            for (int c = 0; c < 1024; ++c) acc += vs[tok * 1024 + c] * p.v_down[c * 32 + o];
            vdl[tok * 32 + o] = acc; }
        __syncthreads();
        for (int i = 0; i < 2; ++i) {
            const int c = tid + 512 * i, head = c >> 6;
            float aw0[PT], aw1[PT], aa0[PT], aa1[PT], ag[PT], avm[PT];
            { const float b0 = p.w0[c], b1 = p.w0[1024 + c], c0 = p.a0[c], c1 = p.a0[1024 + c], d0 = p.layer > 0 ? p.v0[c] : 0.f;
#pragma unroll
              for (int k = 0; k < PT; ++k) { aw0[k] = b0; aw1[k] = b1; aa0[k] = c0; aa1[k] = c1; ag[k] = 0.f; avm[k] = d0; } }
            for (int m = 0; m < 64; ++m) {
                const float u0 = p.w_up[(size_t)m * 1024 + c], u1 = p.w_up[(size_t)(64 + m) * 1024 + c], q0 = p.a_up[(size_t)m * 1024 + c], q1 = p.a_up[(size_t)(64 + m) * 1024 + c];
#pragma unroll
                for (int k = 0; k < PT; ++k) { aw0[k] += sm[k * 416 + m] * u0; aw1[k] += sm[k * 416 + 64 + m] * u1; aa0[k] += sm[k * 416 + 128 + m] * q0; aa1[k] += sm[k * 416 + 192 + m] * q1; }
            }
            for (int m = 0; m < 160; ++m) { const float gu = p.g_up[(size_t)m * 1024 + c];
#pragma unroll
                for (int k = 0; k < PT; ++k) ag[k] += sm[k * 416 + 256 + m] * gu; }
            if (p.layer > 0)
                for (int o = 0; o < 32; ++o) { const float vu = p.v_up[(size_t)o * 1024 + c];
#pragma unroll
                    for (int k = 0; k < PT; ++k) avm[k] += vdl[k * 32 + o] * vu; }
            const float kkw = p.k_k[c], kaw = p.k_a[c], rkw = p.r_k[c];
#pragma unroll
            for (int k = 0; k < PT; ++k) {
                const int t = t0 + k; const size_t o = (size_t)t * 1024 + c;
                const float r = zshift(p.Z, p.mu_p, p.mu_n, t, COL_R + c), kx = zshift(p.Z, p.mu_p, p.mu_n, t, COL_K + c);
                float v = vs[k * 1024 + c];
                if (p.layer > 0) { const float gate = sigmoidf_(avm[k]); const float vf = bf2f(p.VFIRST[o]); v = v + (vf - v) * gate; }
                const float lw0 = -0.6065306597126334f * sigmoidf_(aw0[k]), lw1 = -0.6065306597126334f * sigmoidf_(aw1[k]);
                const float a_0 = sigmoidf_(aa0[k]), a_1 = sigmoidf_(aa1[k]);
                const float kkr = kx * kkw; const float n2 = wave_sum(kkr * kkr);
                const float kk = kkr / fmaxf(sqrtf(n2), 1e-12f);
                const float kd0 = kx * (1.f + (a_0 - 1.f) * kaw), kd1 = kx * (1.f + (a_1 - 1.f) * kaw);
                const float bon = wave_sum(r * (kd0 + kd1) * rkw);
                p.R[o] = (bf16)f2bf(r); p.V[o] = (bf16)f2bf(v); p.KK[o] = (bf16)f2bf(kk); p.KD0[o] = (bf16)f2bf(kd0); p.KD1[o] = (bf16)f2bf(kd1);
                p.B0[o] = (bf16)f2bf(kk * a_0); p.B1[o] = (bf16)f2bf(kk * a_1); p.G[o] = (bf16)f2bf(ag[k]); p.LW0[o] = lw0; p.LW1[o] = lw1;
                if (lane == 0) p.BONUS[t * 16 + head] = bon;
            }
        }
        __syncthreads();
    }
}


namespace pg8 {
#define PG8_LAS __attribute__((address_space(3)))
typedef unsigned short bf16_t;
typedef short bf16x8 __attribute__((ext_vector_type(8)));
typedef float f32x4 __attribute__((ext_vector_type(4)));
typedef unsigned u32x4 __attribute__((ext_vector_type(4)));
constexpr int BM = 256, BK = 64, HALF = 128, HTB = HALF * BK * 2  , STAGE_BYTES = 8 * HTB, NXCD = 8, WGM = 8;

__host__ __device__ __forceinline__ int lds_byte(int r, int c) { const int st = (r >> 4) * 2 + (c >> 5), rr = r & 15, cc = c & 31, ob = rr * 64 + cc * 2; return st * 1024 + (ob ^ (((ob >> 9) & 1) << 5)); }
__host__ __device__ __forceinline__ void stage_rc(int b, int& R, int& C) { const int st = b / 1024, sb = b % 1024, swz = sb ^ (((sb >> 9) & 1) << 5); R = (st >> 1) * 16 + swz / 64; C = (st & 1) * 32 + (swz % 64) / 2; }
__host__ __device__ __forceinline__ int perm32(int rho) { const int n = rho >> 4, i = rho & 15; return 8 * (i >> 2) + 4 * n + (i & 3); }

struct Unit { int pm, pn; };
struct Gemm { const bf16_t* A; const bf16_t* Bt; int M, N, K; };

struct StaticOrder {
    int nM, nN, nwg, G, c;
    __host__ __device__ void init(int M, int N, int G_, int c_) { nM = M / BM; nN = N / BM; nwg = nM * nN; G = G_; c = c_; }
    __host__ __device__ bool next(int i, Unit& u) const {
        const long L = (long)i * G + c; if (L >= nwg) return false;
        int wgid = (int)L; { const int q = nwg / NXCD, r = nwg % NXCD, xcd = wgid % NXCD, off = wgid / NXCD; wgid = (xcd < r ? xcd * (q + 1) : r * (q + 1) + (xcd - r) * q) + off; }
        const int nig = WGM * nN, gid = wgid / nig, fm = gid * WGM, gsz = (nM - fm) < WGM ? (nM - fm) : WGM;
        u.pm = fm + ((wgid % nig) % gsz); u.pn = (wgid % nig) / gsz; return true;
    }
    __device__ __forceinline__ void a_ready(const Unit&) const {}
    __device__ __forceinline__ void done(const Unit&) const {}
};


__device__ __forceinline__ unsigned cvt_pk_bf16(float lo, float hi) { unsigned r; asm volatile("v_cvt_pk_bf16_f32 %0, %1, %2" : "=v"(r) : "v"(lo), "v"(hi)); return r; }

typedef float f32x2 __attribute__((ext_vector_type(2)));
struct EpiBf16S {
    static constexpr bool PERM = true, AFTER_DRAIN = false, MID = false;
    bf16_t* O; int ldc; float scale;
    __device__ __forceinline__ void operator()(const f32x4 (&acc)[2][2][4][2], const Unit& u, int wr, int wc, int fr, int fq) const {
        int row0 = u.pm * BM + wr * 64 + fr; asm volatile("" : "+v"(row0)); const int col0 = u.pn * BM + wc * 32 + 8 * fq;
#pragma unroll
        for (int ai = 0; ai < 2; ++ai)
#pragma unroll
            for (int m = 0; m < 4; ++m) { bf16_t* rowp = O + (size_t)(row0 + ai * HALF + m * 16) * ldc + col0;
#pragma unroll
                for (int bj = 0; bj < 2; ++bj) { const f32x4 v0 = acc[ai][bj][m][0] * scale, v1 = acc[ai][bj][m][1] * scale;
                    u32x4 w; w.x = cvt_pk_bf16(v0[0], v0[1]); w.y = cvt_pk_bf16(v0[2], v0[3]); w.z = cvt_pk_bf16(v1[0], v1[1]); w.w = cvt_pk_bf16(v1[2], v1[3]);
                    *(u32x4*)(rowp + bj * HALF) = w; } }
    }
};
struct EpiF32 {
    static constexpr bool PERM = false, AFTER_DRAIN = false, MID = false;
    float* O; int ldc;
    __device__ __forceinline__ void operator()(const f32x4 (&acc)[2][2][4][2], const Unit& u, int wr, int wc, int fr, int fq) const {
        int row0 = u.pm * BM + wr * 64 + fr; asm volatile("" : "+v"(row0)); const int col0 = u.pn * BM + wc * 32 + 4 * fq;
#pragma unroll
        for (int ai = 0; ai < 2; ++ai)
#pragma unroll
            for (int m = 0; m < 4; ++m) { float* rowp = O + (size_t)(row0 + ai * HALF + m * 16) * ldc + col0;
#pragma unroll
                for (int bj = 0; bj < 2; ++bj)
#pragma unroll
                    for (int n = 0; n < 2; ++n) *(f32x4*)(rowp + bj * HALF + n * 16) = acc[ai][bj][m][n]; }
    }
};
__device__ __forceinline__ float silu_mul(float g, float u) { return g * u * __builtin_amdgcn_rcpf(1.0f + __expf(-g)); }
struct EpiSwiGLU {
    static constexpr bool PERM = true, AFTER_DRAIN = false, MID = false;
    bf16_t* O; int ldc;
    __device__ __forceinline__ void operator()(const f32x4 (&acc)[2][2][4][2], const Unit& u, int wr, int wc, int fr, int fq) const {
        int row0 = u.pm * BM + wr * 64 + fr; asm volatile("" : "+v"(row0)); const int col0 = u.pn * HALF + wc * 32 + 8 * fq;
#pragma unroll
        for (int ai = 0; ai < 2; ++ai)
#pragma unroll
            for (int m = 0; m < 4; ++m) { bf16_t* rowp = O + (size_t)(row0 + ai * HALF + m * 16) * ldc + col0;
                const f32x4 g0 = acc[ai][0][m][0], g1 = acc[ai][0][m][1], u0 = acc[ai][1][m][0], u1 = acc[ai][1][m][1];
                u32x4 w; w.x = cvt_pk_bf16(silu_mul(g0[0], u0[0]), silu_mul(g0[1], u0[1])); w.y = cvt_pk_bf16(silu_mul(g0[2], u0[2]), silu_mul(g0[3], u0[3]));
                w.z = cvt_pk_bf16(silu_mul(g1[0], u1[0]), silu_mul(g1[1], u1[1])); w.w = cvt_pk_bf16(silu_mul(g1[2], u1[2]), silu_mul(g1[3], u1[3]));
                *(u32x4*)rowp = w; }
    }
};
struct EpiMerge {
    static constexpr bool PERM = true, AFTER_DRAIN = false, MID = true;
    const bf16_t* Z; bf16_t* O;
    __device__ __forceinline__ static void unpack8(const u32x4 r, float (&f)[8]) {
        f[0] = __builtin_bit_cast(float, r.x << 16); f[1] = __builtin_bit_cast(float, r.x & 0xffff0000u); f[2] = __builtin_bit_cast(float, r.y << 16); f[3] = __builtin_bit_cast(float, r.y & 0xffff0000u);
        f[4] = __builtin_bit_cast(float, r.z << 16); f[5] = __builtin_bit_cast(float, r.z & 0xffff0000u); f[6] = __builtin_bit_cast(float, r.w << 16); f[7] = __builtin_bit_cast(float, r.w & 0xffff0000u);
    }
    __device__ __forceinline__ void mid(f32x4 (&acc)[2][2][4][2], const Unit& u, int wr, int wc, int fr, int fq) const {
        int row0 = u.pm * BM + wr * 64 + fr; asm volatile("" : "+v"(row0)); const int col0 = u.pn * BM + wc * 32 + 8 * fq;
#pragma unroll
        for (int ai = 0; ai < 2; ++ai)
#pragma unroll
            for (int m = 0; m < 4; ++m) { const bf16_t* zr = Z + (size_t)(row0 + ai * HALF + m * 16) * ZP + col0;
#pragma unroll
                for (int bj = 0; bj < 2; ++bj) { float a[8], b[8]; unpack8(*(const u32x4*)(zr + COL_G1 + bj * HALF), a); unpack8(*(const u32x4*)(zr + COL_G2 + bj * HALF), b);
#pragma unroll
                    for (int e = 0; e < 8; ++e) { const float r = (1.0f + __expf(-fmaxf(b[e], -60.f))) * __builtin_amdgcn_rcpf(1.0f + __expf(-a[e])); acc[ai][bj][m][e >> 2][e & 3] *= r; } }
                if (m & 1) asm volatile("" ::: "memory"); }
    }
    __device__ __forceinline__ void operator()(const f32x4 (&acc)[2][2][4][2], const Unit& u, int wr, int wc, int fr, int fq) const {
        int row0 = u.pm * BM + wr * 64 + fr; asm volatile("" : "+v"(row0)); const int col0 = u.pn * BM + wc * 32 + 8 * fq;
#pragma unroll
        for (int ai = 0; ai < 2; ++ai)
#pragma unroll
            for (int m = 0; m < 4; ++m) { const bf16_t* zr = Z + (size_t)(row0 + ai * HALF + m * 16) * ZP + col0; bf16_t* rowp = O + (size_t)(row0 + ai * HALF + m * 16) * 2048 + col0;
#pragma unroll
                for (int bj = 0; bj < 2; ++bj) { float b[8], o[8]; unpack8(*(const u32x4*)(zr + COL_G2 + bj * HALF), b);
#pragma unroll
                    for (int e = 0; e < 8; ++e) o[e] = acc[ai][bj][m][e >> 2][e & 3] * __builtin_amdgcn_rcpf(1.0f + __expf(-fmaxf(b[e], -60.f)));
                    u32x4 w; w.x = cvt_pk_bf16(o[0], o[1]); w.y = cvt_pk_bf16(o[2], o[3]); w.z = cvt_pk_bf16(o[4], o[5]); w.w = cvt_pk_bf16(o[6], o[7]);
                    *(u32x4*)(rowp + bj * HALF) = w; }
                if (m & 1) asm volatile("" ::: "memory"); }
    }
};
template <class Epi, class Sched, bool ALIGN_EPI = false, bool SP2 = false>
__device__ __forceinline__ void gemm_phase(PG8_LAS unsigned char* lds, const Gemm g, const Sched& S, const Epi& E, int wv) {
    int lane_l = lane_id(); asm volatile("" : "+v"(lane_l));
    asm volatile("" : "+s"(wv));
    const int wid = __builtin_amdgcn_readfirstlane(wv), tid = wid * 64 + lane_l, lane = lane_l, wr = wid >> 2, wc = wid & 3, fr = lane & 15, fq = lane >> 4;
    const int K = g.K, nt = K / BK;
    unsigned voffA[2], voffB[2];
#pragma unroll
    for (int i = 0; i < 2; ++i) { int R, C; stage_rc(tid * 16 + i * 8192, R, C); const int Rb = Epi::PERM ? ((R & ~31) + perm32(R & 31)) : R;
        voffA[i] = (unsigned)(R * K + C) * 2u; voffB[i] = (unsigned)(Rb * K + C) * 2u; }
    const size_t kstep = (size_t)(BK * 2);
    const size_t hstep = (size_t)HALF * K * 2;
    const size_t tstep = 2 * hstep;
    const unsigned ldsw = (unsigned)wid * 1024u;
    const int aoff = lds_byte(wr * 64 + fr, fq * 8), boff = lds_byte(wc * 32 + fr, fq * 8);
#define PG8_SA(b, h) (((b) * 2 + (h)) * HTB)
#define PG8_SB(b, h) ((4 + (b) * 2 + (h)) * HTB)
#define PG8_STAGE(bufoff, gbase, voff) do { _Pragma("unroll") for (int _i = 0; _i < 2; ++_i) \
        __builtin_amdgcn_global_load_lds((const unsigned*)((const char*)(gbase) + (voff)[_i]), (PG8_LAS unsigned*)(lds + (bufoff) + ldsw + _i * 8192), 16, 0, 0); } while (0)
#define PG8_LDA(dst, b, h) do { _Pragma("unroll") for (int m = 0; m < 4; ++m) _Pragma("unroll") for (int k = 0; k < 2; ++k) dst[m][k] = *(const PG8_LAS bf16x8*)(lds + PG8_SA(b, h) + aoff + m * 2048 + k * 1024); } while (0)
#define PG8_LDB(dst, b, h) do { _Pragma("unroll") for (int n = 0; n < 2; ++n) _Pragma("unroll") for (int k = 0; k < 2; ++k) dst[n][k] = *(const PG8_LAS bf16x8*)(lds + PG8_SB(b, h) + boff + n * 2048 + k * 1024); } while (0)
#define PG8_MMA(ai, bj, At, Bt) do { __builtin_amdgcn_s_setprio(1); _Pragma("unroll") for (int m = 0; m < 4; ++m) _Pragma("unroll") for (int n = 0; n < 2; ++n) _Pragma("unroll") for (int k = 0; k < 2; ++k) \
        acc[ai][bj][m][n] = __builtin_amdgcn_mfma_f32_16x16x32_bf16(Bt[n][k], At[m][k], acc[ai][bj][m][n], 0, 0, 0); __builtin_amdgcn_s_setprio(0); } while (0)
#define PG8_WAIT_V(n) asm volatile("s_waitcnt vmcnt(" #n ")" ::: "memory")
#define PG8_WAIT_L(n) asm volatile("s_waitcnt lgkmcnt(" #n ")" ::: "memory")
#define PG8_BAR __builtin_amdgcn_s_barrier()
#define PG8_SCHED __builtin_amdgcn_sched_barrier(0)
    Unit cur, nxt; int ui = 0;
    if (!S.next(0, cur)) return;
    f32x4 acc[2][2][4][2];
#pragma unroll
    for (int a = 0; a < 2; ++a)
#pragma unroll
        for (int b = 0; b < 2; ++b)
#pragma unroll
            for (int m = 0; m < 4; ++m)
#pragma unroll
                for (int n = 0; n < 2; ++n) acc[a][b][m][n] = (f32x4){0.f, 0.f, 0.f, 0.f};
    bf16x8 At[4][2], B0[2][2], B1[2][2];
    const char* cA = (const char*)g.A + (size_t)cur.pm * tstep; const char* cB = (const char*)g.Bt + (size_t)cur.pn * tstep;
    S.a_ready(cur);
    if constexpr (SP2) {
        PG8_STAGE(PG8_SB(0, 0), cB, voffB); PG8_STAGE(PG8_SB(0, 1), cB + hstep, voffB); PG8_STAGE(PG8_SA(0, 0), cA, voffA); PG8_STAGE(PG8_SA(0, 1), cA + hstep, voffA);
        if (wr == 1) PG8_BAR;
        PG8_WAIT_V(2); PG8_BAR;
        PG8_STAGE(PG8_SB(1, 0), cB + kstep, voffB); PG8_STAGE(PG8_SA(1, 0), cA + kstep, voffA); PG8_STAGE(PG8_SB(1, 1), cB + hstep + kstep, voffB);
        PG8_WAIT_V(6); PG8_BAR;
    } else {
        PG8_STAGE(PG8_SB(0, 0), cB, voffB); PG8_STAGE(PG8_SA(0, 0), cA, voffA); PG8_STAGE(PG8_SB(0, 1), cB + hstep, voffB); PG8_STAGE(PG8_SA(0, 1), cA + hstep, voffA);
        if (wr == 1) PG8_BAR;
        PG8_WAIT_V(4); PG8_BAR;
        PG8_STAGE(PG8_SB(1, 0), cB + kstep, voffB); PG8_STAGE(PG8_SA(1, 0), cA + kstep, voffA); PG8_STAGE(PG8_SB(1, 1), cB + hstep + kstep, voffB);
        PG8_WAIT_V(6); PG8_BAR;
    }
    for (;;) {
        const bool has_next = S.next(ui + 1, nxt);
        const char* nA = has_next ? (const char*)g.A + (size_t)nxt.pm * tstep : cA; const char* nB = has_next ? (const char*)g.Bt + (size_t)nxt.pn * tstep : cB;
        for (int t = 0; t < nt; t += 2) {
            const bool last = (t == nt - 2);
            if constexpr (Epi::MID) { if (t == (nt >> 1)) E.mid(acc, cur, wr, wc, fr, fq); }
            const char* a1 = cA + (size_t)(t + 1) * kstep;
            const char* a2 = last ? nA : cA + (size_t)(t + 2) * kstep; const char* b2 = last ? nB : cB + (size_t)(t + 2) * kstep;
            const char* a3 = a2 + kstep; const char* b3 = b2 + kstep;
            if (last && has_next) S.a_ready(nxt);
            if constexpr (SP2) {
            PG8_LDB(B0, 0, 0); PG8_LDB(B1, 0, 1); PG8_SCHED; PG8_LDA(At, 0, 0); PG8_STAGE(PG8_SA(1, 1), a1 + hstep, voffA);
            PG8_WAIT_V(8); PG8_WAIT_L(0); PG8_BAR; PG8_MMA(0, 0, At, B0); PG8_MMA(0, 1, At, B1); PG8_BAR; PG8_SCHED;
            PG8_LDA(At, 0, 1); PG8_STAGE(PG8_SB(0, 0), b2, voffB); PG8_STAGE(PG8_SB(0, 1), b2 + hstep, voffB); PG8_STAGE(PG8_SA(0, 0), a2, voffA);
            PG8_WAIT_V(8); PG8_WAIT_L(0); PG8_BAR; PG8_MMA(1, 0, At, B0); PG8_MMA(1, 1, At, B1); PG8_BAR; PG8_SCHED;
            PG8_LDB(B0, 1, 0); PG8_LDB(B1, 1, 1); PG8_SCHED; PG8_LDA(At, 1, 0); PG8_STAGE(PG8_SA(0, 1), a2 + hstep, voffA);
            PG8_WAIT_V(8); PG8_WAIT_L(0); PG8_BAR; PG8_MMA(0, 0, At, B0); PG8_MMA(0, 1, At, B1); PG8_BAR; PG8_SCHED;
            PG8_LDA(At, 1, 1); PG8_STAGE(PG8_SB(1, 0), b3, voffB); PG8_STAGE(PG8_SB(1, 1), b3 + hstep, voffB); PG8_STAGE(PG8_SA(1, 0), a3, voffA);
            PG8_WAIT_V(8); PG8_WAIT_L(0); PG8_BAR; PG8_MMA(1, 0, At, B0); PG8_MMA(1, 1, At, B1); PG8_BAR; PG8_SCHED;
            } else {
            PG8_LDB(B0, 0, 0); PG8_SCHED; PG8_LDA(At, 0, 0); PG8_STAGE(PG8_SA(1, 1), a1 + hstep, voffA);
            PG8_WAIT_L(8); PG8_BAR; PG8_WAIT_L(0); PG8_MMA(0, 0, At, B0); PG8_BAR; PG8_SCHED;
            PG8_LDB(B1, 0, 1); PG8_STAGE(PG8_SB(0, 0), b2, voffB);
            PG8_BAR; PG8_WAIT_L(0); PG8_MMA(0, 1, At, B1); PG8_BAR;
            PG8_LDA(At, 0, 1); PG8_STAGE(PG8_SA(0, 0), a2, voffA);
            PG8_BAR; PG8_WAIT_L(0); PG8_MMA(1, 0, At, B0); PG8_BAR; PG8_SCHED;
            PG8_STAGE(PG8_SB(0, 1), b2 + hstep, voffB);
            PG8_WAIT_V(6); PG8_BAR; PG8_MMA(1, 1, At, B1); PG8_BAR;
            PG8_LDB(B0, 1, 0); PG8_SCHED; PG8_LDA(At, 1, 0); PG8_STAGE(PG8_SA(0, 1), a2 + hstep, voffA);
            PG8_WAIT_L(8); PG8_BAR; PG8_WAIT_L(0); PG8_MMA(0, 0, At, B0); PG8_BAR; PG8_SCHED;
            PG8_LDB(B1, 1, 1); PG8_STAGE(PG8_SB(1, 0), b3, voffB);
            PG8_BAR; PG8_WAIT_L(0); PG8_MMA(0, 1, At, B1); PG8_BAR;
            PG8_LDA(At, 1, 1); PG8_STAGE(PG8_SA(1, 0), a3, voffA);
            PG8_BAR; PG8_WAIT_L(0); PG8_MMA(1, 0, At, B0); PG8_BAR; PG8_SCHED;
            PG8_STAGE(PG8_SB(1, 1), b3 + hstep, voffB);
            PG8_WAIT_V(6); PG8_BAR; PG8_MMA(1, 1, At, B1); PG8_BAR;
            }
        }
        if constexpr (ALIGN_EPI) { if (wr == 0) PG8_BAR; }
        if constexpr (!Epi::AFTER_DRAIN) { E(acc, cur, wr, wc, fr, fq); S.done(cur); }
        if (!has_next) break;
#pragma unroll
        for (int a = 0; a < 2; ++a)
#pragma unroll
            for (int b = 0; b < 2; ++b)
#pragma unroll
                for (int m = 0; m < 4; ++m)
#pragma unroll
                    for (int n = 0; n < 2; ++n) acc[a][b][m][n] = (f32x4){0.f, 0.f, 0.f, 0.f};
        cur = nxt; cA = nA; cB = nB; ++ui;
        if constexpr (ALIGN_EPI) { if (wr == 1) PG8_BAR; }
    }
    PG8_WAIT_V(0);
    if constexpr (!ALIGN_EPI) { if (wr == 0) PG8_BAR; }
    PG8_BAR;
    if constexpr (Epi::AFTER_DRAIN) { E.fused(acc, cur, wr, wc, fr, fq, lds, wid, lane); S.done(cur); }
#undef PG8_SA
#undef PG8_SB
#undef PG8_STAGE
#undef PG8_LDA
#undef PG8_LDB
#undef PG8_MMA
#undef PG8_WAIT_V
#undef PG8_WAIT_L
#undef PG8_BAR
#undef PG8_SCHED
}
}


#include <hip/hip_bf16.h>
#include <cmath>
namespace attn_body {
using bf16=__hip_bfloat16;
using bf16x8=__attribute__((ext_vector_type(8)))short;
using s16x4=__attribute__((ext_vector_type(4)))short;
using f32x16=__attribute__((ext_vector_type(16)))float;
using u32x4=__attribute__((ext_vector_type(4)))unsigned;
constexpr int NHEAD=16,SEQ=8192,D=64,QP=1024,KVP=256,OP=2048;
constexpr int NW=8,QBLK=32,QB=QBLK*NW,KVBLK=64,NQB=SEQ/QB;
constexpr int ATTN_UNIT_ROWS=QB;
__device__ __forceinline__ int crow(int r,int hi){return (r&3)+8*(r>>2)+4*hi;}
#define SBAR() __builtin_amdgcn_sched_barrier(0)
__device__ __forceinline__ void cmask(f32x16&p0,f32x16&p1,int jb,int qrel,int hi){
  const float NEG=-INFINITY; int kb=64*jb+4*hi;
  #pragma unroll
  for(int r=0;r<16;++r){int kv=kb+(r&3)+8*(r>>2); if(kv>qrel)p0[r]=NEG; if(kv+32>qrel)p1[r]=NEG;}
}

constexpr int NSLOT=3, SLOTB=8192;
constexpr int LDS_K=0, LDS_V=NSLOT*SLOTB, LDS_WS=2*NSLOT*SLOTB, LDS_OST=LDS_WS+NW*64*4, LDS_BYTES=LDS_OST+NW*4096;
constexpr float C2=0.125f*1.4426950408889634f;
__device__ __forceinline__ void glds16(const void*gsrc,unsigned lds_dst){unsigned keep;
  asm volatile("s_mov_b32 %0, m0\n\ts_mov_b32 m0, %2\n\ts_nop 0\n\tglobal_load_lds_dwordx4 %1, off\n\ts_mov_b32 m0, %0":"=&s"(keep):"v"(gsrc),"s"(lds_dst):"memory");}
__device__ __forceinline__ float max3f(float a,float b,float c){float r;asm("v_max3_f32 %0, %1, %2, %3":"=v"(r):"v"(a),"v"(b),"v"(c));return r;}
__device__ __forceinline__ float max2f(float a,float b){float r;asm("v_max_f32_e32 %0, %1, %2":"=v"(r):"v"(a),"v"(b));return r;}
__device__ __forceinline__ float fadd_s(float a,float b){float r;asm("v_add_f32_e32 %0, %1, %2":"=v"(r):"v"(a),"v"(b));return r;}
__device__ __forceinline__ float fsub_s(float a,float b){float r;asm("v_sub_f32_e32 %0, %1, %2":"=v"(r):"v"(a),"v"(b));return r;}
typedef float f32x2_t __attribute__((ext_vector_type(2))); typedef __bf16 bf16x2_t __attribute__((ext_vector_type(2)));
__device__ __forceinline__ unsigned cvtpk_s(float lo,float hi){f32x2_t v={lo,hi};bf16x2_t b=__builtin_convertvector(v,bf16x2_t);return __builtin_bit_cast(unsigned,b);}
#define WAIT_BAR(N) asm volatile("s_waitcnt vmcnt(" #N ") lgkmcnt(0)\n\ts_barrier":::"memory")

__device__ __forceinline__ void qkt(f32x16&p0,f32x16&p1,const char*Kslot,const bf16x8*qr,const f32x16&negm,int r32,int hi){
  const char*kb=Kslot+hi*1024+r32*16;
  #pragma unroll
  for(int d0=0;d0<4;++d0){
    const bf16x8 b0=*reinterpret_cast<const bf16x8*>(kb+d0*2048);
    const bf16x8 b1=*reinterpret_cast<const bf16x8*>(kb+d0*2048+512);
    if(d0==0){p0=__builtin_amdgcn_mfma_f32_32x32x16_bf16(b0,qr[0],negm,0,0,0);p1=__builtin_amdgcn_mfma_f32_32x32x16_bf16(b1,qr[0],negm,0,0,0);}
    else{p0=__builtin_amdgcn_mfma_f32_32x32x16_bf16(b0,qr[d0],p0,0,0,0);p1=__builtin_amdgcn_mfma_f32_32x32x16_bf16(b1,qr[d0],p1,0,0,0);}}
}
typedef __attribute__((address_space(3))) const char* lds_cptr;
typedef short v4i16_t __attribute__((ext_vector_type(4)));
__device__ __forceinline__ void kload8(bf16x8*kf,lds_cptr kp){
  kf[0]=*(const __attribute__((address_space(3))) bf16x8*)(kp);      kf[1]=*(const __attribute__((address_space(3))) bf16x8*)(kp+512);
  kf[2]=*(const __attribute__((address_space(3))) bf16x8*)(kp+2048); kf[3]=*(const __attribute__((address_space(3))) bf16x8*)(kp+2560);
  kf[4]=*(const __attribute__((address_space(3))) bf16x8*)(kp+4096); kf[5]=*(const __attribute__((address_space(3))) bf16x8*)(kp+4608);
  kf[6]=*(const __attribute__((address_space(3))) bf16x8*)(kp+6144); kf[7]=*(const __attribute__((address_space(3))) bf16x8*)(kp+6656);
}
__device__ __forceinline__ void kload2(bf16x8*kf,lds_cptr kp,int j){ kf[2*j]=*(const __attribute__((address_space(3))) bf16x8*)(kp+j*2048); kf[2*j+1]=*(const __attribute__((address_space(3))) bf16x8*)(kp+j*2048+512); }
__device__ __forceinline__ s16x4 vtr(lds_cptr p){ return __builtin_bit_cast(s16x4,__builtin_amdgcn_ds_read_tr16_b64_v4i16((__attribute__((address_space(3))) v4i16_t*)p)); }
__device__ __forceinline__ float rowmax(const f32x16&p0,const f32x16&p1){
  float a=max3f(p0[0],p0[1],p1[0]),b=max3f(p0[2],p0[3],p1[1]);a=max3f(a,p1[2],p1[3]);
  #pragma unroll
  for(int r=4;r<16;r+=4){a=max3f(a,p0[r],p0[r+1]);b=max3f(b,p0[r+2],p0[r+3]);a=max3f(a,p1[r],p1[r+1]);b=max3f(b,p1[r+2],p1[r+3]);}
  const float m=max2f(a,b);
  auto rr=__builtin_amdgcn_permlane32_swap(__float_as_uint(m),__float_as_uint(m),false,false);
  return max2f(__uint_as_float(rr[0]),__uint_as_float(rr[1]));
}
__device__ __forceinline__ void pv(f32x16*o,int vb,bf16x8 pa0,bf16x8 pa1,bf16x8 pa2,bf16x8 pa3){
  #pragma unroll
  for(int d0=0;d0<2;++d0){s16x4 lo[4],hi[4];
    #pragma unroll
    for(int ks=0;ks<4;++ks){
      asm volatile("ds_read_b64_tr_b16 %0,%1 offset:%c2":"=&v"(lo[ks]):"v"(vb),"i"(d0*4096+ks*1024):"memory");
      asm volatile("ds_read_b64_tr_b16 %0,%1 offset:%c2":"=&v"(hi[ks]):"v"(vb),"i"(d0*4096+ks*1024+512):"memory");}
    asm volatile("s_waitcnt lgkmcnt(0)":::"memory");SBAR();
    #define PK(k) (bf16x8){lo[k][0],lo[k][1],lo[k][2],lo[k][3],hi[k][0],hi[k][1],hi[k][2],hi[k][3]}
    o[d0]=__builtin_amdgcn_mfma_f32_32x32x16_bf16(pa0,PK(0),o[d0],0,0,0);
    o[d0]=__builtin_amdgcn_mfma_f32_32x32x16_bf16(pa1,PK(1),o[d0],0,0,0);
    o[d0]=__builtin_amdgcn_mfma_f32_32x32x16_bf16(pa2,PK(2),o[d0],0,0,0);
    o[d0]=__builtin_amdgcn_mfma_f32_32x32x16_bf16(pa3,PK(3),o[d0],0,0,0);
    #undef PK
  }
}

#ifndef ATTN_STORE16
#define ATTN_STORE16(p,v) (*(u32x4*)(p)=(v))
#endif
template<int THRL> __device__ __forceinline__ void attn_unit(int wv,int b,int h,int qb,const bf16*Q,const bf16*__restrict__ K,const bf16*__restrict__ V,bf16*O,char*shm){
  int lane_l=lane_id(); asm volatile("":"+v"(lane_l)); asm volatile("":"+s"(wv)); const int lane=lane_l,r32=lane&31,hi=lane>>5; const int wid=__builtin_amdgcn_readfirstlane(wv); const int tid=wid*64+lane; (void)tid;
  const int q0=qb*QB; (void)b;
  const bf16*Qw=Q+(long)(q0+wid*QBLK)*QP+h*D;
  const bf16*Kh=K+(h>>2)*D,*Vh=V+(h>>2)*D;
  const unsigned lds0=(unsigned)(uintptr_t)shm;
  float*wsf=(float*)(shm+LDS_WS)+wid*64;
  const bf16*ksrc=Kh+(long)lane*KVP+wid*8;
  const bf16*vsrc=Vh+(long)(16*(wid&3)+(lane>>2))*KVP+(wid>>2)*32+(lane&3)*8;
  const unsigned kdst=lds0+LDS_K+wid*1024, vdst=lds0+LDS_V+wid*1024;
  #define DMA_K(t,slot) glds16(ksrc+(long)(t)*KVBLK*KVP,(unsigned)__builtin_amdgcn_readfirstlane(kdst+(slot)))
  #define DMA_V(t,slot) glds16(vsrc+(long)(t)*KVBLK*KVP,(unsigned)__builtin_amdgcn_readfirstlane(vdst+(slot)))
  const int vb0=(int)(lds0+LDS_V)+((lane>>4)&1)*32+(lane&3)*8+(4*hi+((lane&15)>>2))*64;
  const char*Kbase=shm+LDS_K; bf16x8 kf[8];
  const lds_cptr shm3=(lds_cptr)shm; const lds_cptr kp0=shm3+LDS_K+hi*1024+r32*16; const lds_cptr vp0=shm3+LDS_V+((lane>>4)&1)*32+(lane&3)*8+(4*hi+((lane&15)>>2))*64;
  const int NT=SEQ/KVBLK;
  DMA_K(0,0);DMA_V(0,0);DMA_K(1,SLOTB);
  bf16x8 qr[4];
  #pragma unroll
  for(int d0=0;d0<4;++d0)qr[d0]=*reinterpret_cast<const bf16x8*>(&Qw[(long)r32*QP+d0*16+hi*8]);
  float mhat=0.f,l_reg=0.f;f32x16 o[2];o[0]=f32x16{};o[1]=f32x16{};f32x16 negm=f32x16{};asm volatile("":"+v"(negm));
  const int qrel=wid*QBLK+r32;
  #define CMASK(P0,P1,t) do{}while(0)
  bool resc=false;
  #define START(P0,P1) do{ const float rm=rowmax(P0,P1); resc=false; \
    { const float dl=rm; mhat=fadd_s(mhat,dl); \
      _Pragma("unroll") for(int r=0;r<16;++r){P0[r]=fsub_s(P0[r],dl);P1[r]=fsub_s(P1[r],dl);} \
      _Pragma("unroll") for(int r=0;r<16;++r)negm[r]=-mhat; asm volatile("":"+v"(negm)); } \
    _Pragma("unroll") for(int r=0;r<16;++r)P0[r]=__builtin_amdgcn_exp2f(P0[r]); }while(0)
  #define RESC() do{ if(resc){ asm volatile("s_waitcnt lgkmcnt(0)":::"memory"); \
      _Pragma("unroll") for(int d_=0;d_<2;++d_) _Pragma("unroll") for(int r=0;r<16;++r)o[d_][r]*=wsf[crow(r,hi)]; } }while(0)
  f32x16 pA0,pA1,pB0,pB1;
  int sl_prev=0,sl_cur=0,sl_next=SLOTB;
  #define ROT() do{sl_prev=sl_cur;sl_cur=sl_next;sl_next=(sl_next==(NSLOT-1)*SLOTB)?0:sl_next+SLOTB;}while(0)
  DMA_K(2,2*SLOTB);
  WAIT_BAR(3);
  qkt(pA0,pA1,Kbase,qr,negm,r32,hi);asm volatile("s_nop 15\n\ts_nop 7":"+v"(pA0),"+v"(pA1));CMASK(pA0,pA1,0);
  START(pA0,pA1);
  _Pragma("unroll") for(int r=0;r<16;++r)pA1[r]=__builtin_amdgcn_exp2f(pA1[r]);
  WAIT_BAR(0);
  DMA_K(3,0);DMA_V(1,SLOTB);
  ROT();
  kload8(kf,kp0+sl_cur);
  WAIT_BAR(2);
  s16x4 vlo[8],vhi[8]; u32x4 pw0,pw1,pw2,pw3;
  #define PKW(P,B) cvtpk_s(P[B],P[B+1])
  #define PAF(k) __builtin_bit_cast(bf16x8,pw##k)
  #define VFR(i) (bf16x8){vlo[i][0],vlo[i][1],vlo[i][2],vlo[i][3],vhi[i][0],vhi[i][1],vhi[i][2],vhi[i][3]}
  #define PIN(x) asm volatile("":"+v"(x))
  #define MX3(a,b,c) __builtin_fmaxf(__builtin_fmaxf((a),(b)),(c))
  #define GAPA(MF,A0,A1,A2,A3,W0,W1,PW) do{ MF; sacc+=A0; sacc+=A1; sacc+=A2; sacc+=A3; PIN(sacc); W0; W1; PIN(PW); SBAR(); }while(0)
  #define EX(v) __builtin_amdgcn_exp2f(v)
  #define GAPB(MF,X,B) do{ MF; X[B]=EX(X[B]); X[B+1]=EX(X[B+1]); X[B+2]=EX(X[B+2]); X[B+3]=EX(X[B+3]); PIN(X); SBAR(); }while(0)
  #define VRD(i) do{ vlo[i]=vtr(vp_+(((i)>>2)*4096+((i)&3)*1024)); vhi[i]=vtr(vp_+(((i)>>2)*4096+((i)&3)*1024+512)); }while(0)
  #define KRD(G,j) do{ if(G){ kload2(kf,kp0+sl_next,j); SBAR(); } }while(0)
  #define STEP(C0,C1,P0,P1,t,GK,GV,GL) do{ SBAR(); \
    const lds_cptr vp_=vp0+sl_prev; \
    VRD(0); SBAR(); float sacc=(P0[0]+P0[1]); \
    GAPA(C0=__builtin_amdgcn_mfma_f32_32x32x16_bf16(kf[0],qr[0],negm,0,0,0), P0[2],P0[3],P0[4],P0[5],     pw0[0]=PKW(P0,0), pw0[1]=PKW(P0,2), pw0); \
    VRD(4); SBAR(); GAPA(C1=__builtin_amdgcn_mfma_f32_32x32x16_bf16(kf[1],qr[0],negm,0,0,0), P0[6],P0[7],P0[8],P0[9],     pw0[2]=PKW(P0,4), pw0[3]=PKW(P0,6), pw0); \
    VRD(1); SBAR(); GAPA(C0=__builtin_amdgcn_mfma_f32_32x32x16_bf16(kf[2],qr[1],C0,0,0,0),   P0[10],P0[11],P0[12],P0[13], pw1[0]=PKW(P0,8), pw1[1]=PKW(P0,10), pw1); \
    VRD(5); SBAR(); GAPA(C1=__builtin_amdgcn_mfma_f32_32x32x16_bf16(kf[3],qr[1],C1,0,0,0),   P0[14],P0[15],P1[0],P1[1],   pw1[2]=PKW(P0,12),pw1[3]=PKW(P0,14), pw1); \
    VRD(2); SBAR(); GAPA(C0=__builtin_amdgcn_mfma_f32_32x32x16_bf16(kf[4],qr[2],C0,0,0,0),   P1[2],P1[3],P1[4],P1[5],     pw2[0]=PKW(P1,0), pw2[1]=PKW(P1,2), pw2); \
    VRD(6); SBAR(); GAPA(C1=__builtin_amdgcn_mfma_f32_32x32x16_bf16(kf[5],qr[2],C1,0,0,0),   P1[6],P1[7],P1[8],P1[9],     pw2[2]=PKW(P1,4), pw2[3]=PKW(P1,6), pw2); \
    VRD(3); SBAR(); GAPA(C0=__builtin_amdgcn_mfma_f32_32x32x16_bf16(kf[6],qr[3],C0,0,0,0),   P1[10],P1[11],P1[12],P1[13], pw3[0]=PKW(P1,8), pw3[1]=PKW(P1,10), pw3); \
    VRD(7); SBAR(); GAPA(C1=__builtin_amdgcn_mfma_f32_32x32x16_bf16(kf[7],qr[3],C1,0,0,0),   P1[14],P1[15],0.f,0.f,       pw3[2]=PKW(P1,12),pw3[3]=PKW(P1,14), pw3); \
    l_reg+=sacc; \
    if(GK){DMA_K((t)+3,sl_cur);} if(GV){DMA_V((t)+1,sl_next);} \
    CMASK(C0,C1,t); \
    { float a=MX3(C0[0],C0[1],C1[0]),b=MX3(C0[2],C0[3],C1[1]); a=MX3(a,C1[2],C1[3]); \
      _Pragma("unroll") for(int r=4;r<16;r+=4){a=MX3(a,C0[r],C0[r+1]);b=MX3(b,C0[r+2],C0[r+3]);a=MX3(a,C1[r],C1[r+1]);b=MX3(b,C1[r+2],C1[r+3]);} \
      float rm=__builtin_fmaxf(a,b); { auto rr=__builtin_amdgcn_permlane32_swap(__float_as_uint(rm),__float_as_uint(rm),false,false); rm=__builtin_fmaxf(__uint_as_float(rr[0]),__uint_as_float(rr[1])); } \
      resc=false; \
      if(__builtin_expect(__any(rm>(float)THRL),0)){ const float dl=__builtin_fmaxf(rm,0.f); mhat+=dl; \
        _Pragma("unroll") for(int r=0;r<16;++r){C0[r]-=dl;C1[r]-=dl;} \
        _Pragma("unroll") for(int r=0;r<16;++r)negm[r]=-mhat; asm volatile("":"+v"(negm)); \
        const float f=__builtin_amdgcn_exp2f(-dl); l_reg*=f; if(hi==0)wsf[r32]=f; resc=true; } } \
    SBAR(); \
    GAPB(o[0]=__builtin_amdgcn_mfma_f32_32x32x16_bf16(PAF(0),VFR(0),o[0],0,0,0), C0,0); \
    GAPB(o[1]=__builtin_amdgcn_mfma_f32_32x32x16_bf16(PAF(0),VFR(4),o[1],0,0,0), C0,4); \
    KRD(GL,0); GAPB(o[0]=__builtin_amdgcn_mfma_f32_32x32x16_bf16(PAF(1),VFR(1),o[0],0,0,0), C0,8); \
    KRD(GL,1); GAPB(o[1]=__builtin_amdgcn_mfma_f32_32x32x16_bf16(PAF(1),VFR(5),o[1],0,0,0), C0,12); \
    KRD(GL,2); GAPB(o[0]=__builtin_amdgcn_mfma_f32_32x32x16_bf16(PAF(2),VFR(2),o[0],0,0,0), C1,0); \
    KRD(GL,3); GAPB(o[1]=__builtin_amdgcn_mfma_f32_32x32x16_bf16(PAF(2),VFR(6),o[1],0,0,0), C1,4); \
    GAPB(o[0]=__builtin_amdgcn_mfma_f32_32x32x16_bf16(PAF(3),VFR(3),o[0],0,0,0), C1,8); \
    GAPB(o[1]=__builtin_amdgcn_mfma_f32_32x32x16_bf16(PAF(3),VFR(7),o[1],0,0,0), C1,12); \
    }while(0)
  int t=1;
  #undef CMASK
  #define CMASK(P0,P1,t) do{}while(0)
  for(;t+5<NT;t+=2){
    STEP(pB0,pB1,pA0,pA1,t,true,true,true);     WAIT_BAR(2); RESC(); ROT();
    STEP(pA0,pA1,pB0,pB1,t+1,true,true,true);   WAIT_BAR(2); RESC(); ROT();
  }
  #undef CMASK
  #define CMASK(P0,P1,t) do{}while(0)
  #define ENDW(tt) do{ if((tt)+3<NT){WAIT_BAR(2);} else if((tt)+2<NT){WAIT_BAR(1);} else {WAIT_BAR(0);} }while(0)
  for(;t+1<NT;t+=2){
    STEP(pB0,pB1,pA0,pA1,t,(t+3<NT),(t+1<NT),(t+1<NT));       ENDW(t);   RESC(); ROT();
    STEP(pA0,pA1,pB0,pB1,t+1,(t+4<NT),(t+2<NT),(t+2<NT));     ENDW(t+1); RESC(); ROT();
  }
  STEP(pB0,pB1,pA0,pA1,NT-1,false,false,false); RESC();
  { float sacc=pB0[0]+pB0[1]; _Pragma("unroll") for(int r=2;r<16;++r)sacc+=pB0[r]; _Pragma("unroll") for(int r=0;r<16;++r)sacc+=pB1[r]; l_reg+=sacc;
    pw0=(u32x4){PKW(pB0,0),PKW(pB0,2),PKW(pB0,4),PKW(pB0,6)};pw1=(u32x4){PKW(pB0,8),PKW(pB0,10),PKW(pB0,12),PKW(pB0,14)};pw2=(u32x4){PKW(pB1,0),PKW(pB1,2),PKW(pB1,4),PKW(pB1,6)};pw3=(u32x4){PKW(pB1,8),PKW(pB1,10),PKW(pB1,12),PKW(pB1,14)};
    SBAR(); pv(o,vb0+sl_cur,PAF(0),PAF(1),PAF(2),PAF(3)); }
  #undef PKW
  #undef PAF
  #undef VFR
  #undef PIN
  #undef MX3
  #undef GAPA
  #undef GAPB
  #undef EX
  #undef VRD
  #undef KRD
  #undef STEP
  #undef ENDW
  {auto rr=__builtin_amdgcn_permlane32_swap(__float_as_uint(l_reg),__float_as_uint(l_reg),false,false);l_reg=__uint_as_float(rr[0])+__uint_as_float(rr[1]);}
  if(hi==0)wsf[32+r32]=l_reg;asm volatile("s_waitcnt lgkmcnt(0)":::"memory");
  float rli[16];
  #pragma unroll
  for(int r=0;r<16;++r)rli[r]=__builtin_amdgcn_rcpf(wsf[32+crow(r,hi)]);
  bf16*Ow=O+(long)(q0+wid*QBLK)*OP+h*D;
  { bf16*stg=(bf16*)(shm+LDS_OST)+wid*2048;
    #pragma unroll
    for(int r=0;r<16;++r){const int orow=crow(r,hi);
      #pragma unroll
      for(int d0=0;d0<2;++d0)stg[orow*64+d0*32+r32]=__float2bfloat16(o[d0][r]*rli[r]);}
    asm volatile("s_waitcnt lgkmcnt(0)":::"memory");
    #pragma unroll
    for(int i=0;i<4;++i){const int row=i*8+(lane>>3),ch=lane&7; const u32x4 v=*(const u32x4*)(stg+row*64+ch*8); ATTN_STORE16(Ow+(long)row*OP+ch*8,v);} }
  asm volatile("s_waitcnt lgkmcnt(0)\n\ts_barrier":::"memory");
  #undef DMA_K
  #undef DMA_V
  #undef CMASK
  #undef START
  #undef RESC
  #undef ROT
}
constexpr int ATTN_LDS_BYTES=LDS_BYTES;
struct AttnTensors { const bf16* Q; const bf16* K; const bf16* V; bf16* O; };
struct AttnUnit { int h; int qb; };
struct StaticOrder {
  int vcu, G;
  __device__ __forceinline__ explicit StaticOrder(int grid,int block):vcu((grid%8==0)?(block%8)*(grid/8)+block/8:block),G(grid){}
  __device__ __forceinline__ bool next(int i,AttnUnit&u)const{ const int per=(512+G-1)/G; if(i>=per)return false; const int id=vcu*per+i; if(id>=512)return false; u.h=id>>5; u.qb=id&31; return true; }
  __device__ __forceinline__ void a_ready(const AttnUnit&)const{}
  __device__ __forceinline__ void done(const AttnUnit&)const{}
};
template<class Sched,int THRL=8> __device__ __forceinline__ void attn_phase(char*lds,const AttnTensors&T,const Sched&S,int wv){
  AttnUnit u;
  for(int i=0;S.next(i,u);++i){ S.a_ready(u); attn_unit<THRL>(wv,0,u.h,u.qb,T.Q,T.K,T.V,T.O,lds); S.done(u); }
}
#undef SBAR
#undef WAIT_BAR
}


namespace scan {
constexpr int NCH = S / 64;
constexpr int PB = 72, PAB = 68, PRHS = 129;
constexpr int O_RT = 0, O_BT = 9216, O_AT = 18432, O_KT = 27648, O_BTT = 36864, O_KTT = 46080, O_VT = 55296, O_ARB = 64512, O_ARK = 73728, O_AAK = 82944,
              O_AAB = 92160, O_RHS = 109568, O_XT = O_RHS, O_GS = 142592, O_GC = 144640, S1_LDS = 144896;
struct Args { const bf16 *R, *V, *KK, *KD0, *KD1, *B0, *B1; const float *LW0, *LW1; bf16 *P, *RP, *Q, *YL, *TT; float *GC; };
typedef float f32x4_t __attribute__((ext_vector_type(4)));
__device__ __forceinline__ f32x4_t mma(bf16x8 a, bf16x8 b, f32x4_t c) { return __builtin_amdgcn_mfma_f32_16x16x32_bf16(a, b, c, 0, 0, 0); }
#define S1_BAR() do { asm volatile("s_waitcnt vmcnt(0) lgkmcnt(0)" ::: "memory"); __builtin_amdgcn_s_barrier(); asm volatile("" ::: "memory"); } while (0)
__device__ __forceinline__ bf16x8 ldfrag(const LAS bf16* m, int row, int k0) { return *(const LAS bf16x8*)(m + row * PB + k0); }

template <class T> __device__ __forceinline__ LAS T* lds_ptr(LAS unsigned char* lds, int off) { unsigned a = (unsigned)(uintptr_t)(lds + off); asm volatile("" : "+v"(a)); return (LAS T*)(uintptr_t)a; }
__device__ __forceinline__ void s1_unit(LAS unsigned char* lds, const Args& A, int d, int h, int c, int wv) {
    int lane_l = lane_id(); asm volatile("" : "+v"(lane_l), "+s"(wv));
    const int lane = lane_l, w = __builtin_amdgcn_readfirstlane(wv), tid = w * 64 + lane, l15 = lane & 15, q = lane >> 4;
    LAS bf16* RT = lds_ptr<bf16>(lds, O_RT); LAS bf16* BT = lds_ptr<bf16>(lds, O_BT); LAS bf16* AT = lds_ptr<bf16>(lds, O_AT); LAS bf16* KT = lds_ptr<bf16>(lds, O_KT);
    LAS bf16* BTT = lds_ptr<bf16>(lds, O_BTT); LAS bf16* KTT = lds_ptr<bf16>(lds, O_KTT); LAS bf16* VT = lds_ptr<bf16>(lds, O_VT);
    LAS bf16* ARB = lds_ptr<bf16>(lds, O_ARB); LAS bf16* ARK = lds_ptr<bf16>(lds, O_ARK); LAS bf16* AAK = lds_ptr<bf16>(lds, O_AAK);
    LAS float* AAB = lds_ptr<float>(lds, O_AAB); LAS float* RHS = lds_ptr<float>(lds, O_RHS); LAS bf16* XT = lds_ptr<bf16>(lds, O_XT);
    LAS float* GS = lds_ptr<float>(lds, O_GS); LAS float* GCL = lds_ptr<float>(lds, O_GC);
    const bf16* KD = d ? A.KD1 : A.KD0; const bf16* Bg = d ? A.B1 : A.B0; const float* LW = d ? A.LW1 : A.LW0;
    const int u = (d * 16 + h) * NCH + c;
    {
        const int j = lane, ig = w;
        float lwv[8], cumv[8]; unsigned rr[8], kd[8], kk[8], bb[8], vv[8]; float run = 0.f;
#pragma unroll
        for (int k = 0; k < 8; ++k) { const int i = 8 * ig + k, t = d ? (64 * c + 63 - i) : (64 * c + i); const size_t idx = (size_t)t * 1024 + h * 64 + j;
            lwv[k] = LW[idx]; rr[k] = A.R[idx]; kd[k] = KD[idx]; kk[k] = A.KK[idx]; bb[k] = Bg[idx]; vv[k] = A.V[idx]; }
#pragma unroll
        for (int k = 0; k < 8; ++k) { run += lwv[k]; cumv[k] = run; }
        GS[ig * 64 + j] = run;
        S1_BAR();
        float off = 0.f, tot = 0.f;
#pragma unroll
        for (int g = 0; g < 8; ++g) { const float s = GS[g * 64 + j]; off += (g < ig) ? s : 0.f; tot += s; }
        if (ig == 0) GCL[j] = __expf(tot);
        unsigned btT[8], ktT[8];
#pragma unroll
        for (int k = 0; k < 8; ++k) { const int i = 8 * ig + k; const float cum = off + cumv[k];
            const float e1 = __expf(cum), e2 = __expf(-cum), ex = __expf(cum - lwv[k]);
            const float at = -bf2f(kk[k]) * ex, rt = bf2f(rr[k]) * e1, bt = bf2f(bb[k]) * e2, kt = bf2f(kd[k]) * e2;
            RT[i * PB + j] = (bf16)f2bf(rt); AT[i * PB + j] = (bf16)f2bf(at); btT[k] = f2bf(bt); ktT[k] = f2bf(kt);
            BT[i * PB + j] = (bf16)btT[k]; KT[i * PB + j] = (bf16)ktT[k]; RHS[i * PRHS + j] = at; }
        v4u pb, pk, pv;
        pb.x = btT[0] | (btT[1] << 16); pb.y = btT[2] | (btT[3] << 16); pb.z = btT[4] | (btT[5] << 16); pb.w = btT[6] | (btT[7] << 16);
        pk.x = ktT[0] | (ktT[1] << 16); pk.y = ktT[2] | (ktT[3] << 16); pk.z = ktT[4] | (ktT[5] << 16); pk.w = ktT[6] | (ktT[7] << 16);
        pv.x = vv[0] | (vv[1] << 16); pv.y = vv[2] | (vv[3] << 16); pv.z = vv[4] | (vv[5] << 16); pv.w = vv[6] | (vv[7] << 16);
        *(LAS v4u*)(BTT + j * PB + 8 * ig) = pb; *(LAS v4u*)(KTT + j * PB + 8 * ig) = pk; *(LAS v4u*)(VT + j * PB + 8 * ig) = pv;
        S1_BAR();
    }
    {
        const bool isR = w >= 4; const int ibb = w & 3; const LAS bf16* Lm = isR ? RT : AT;
        const bf16x8 a0 = ldfrag(Lm, 16 * ibb + l15, 8 * q), a1 = ldfrag(Lm, 16 * ibb + l15, 8 * q + 32);
#pragma unroll
        for (int sb = 0; sb < 8; ++sb) { const int sbb = sb & 3; const bool isK = sb >= 4;
            f32x4_t acc = (f32x4_t){0.f, 0.f, 0.f, 0.f};
            if (sbb <= ibb) { const LAS bf16* Rm = isK ? KT : BT; acc = mma(a0, ldfrag(Rm, 16 * sbb + l15, 8 * q), acc); acc = mma(a1, ldfrag(Rm, 16 * sbb + l15, 8 * q + 32), acc); }
#pragma unroll
            for (int r = 0; r < 4; ++r) { const int i = 16 * ibb + 4 * q + r, s = 16 * sbb + l15; const bool keep = isR ? (s <= i) : (s < i); const float val = keep ? acc[r] : 0.f;
                if (!isR && !isK) AAB[i * PAB + s] = val;
                else { LAS bf16* dst = (!isR) ? AAK : (isK ? ARK : ARB); dst[i * PB + s] = (bf16)f2bf(val); } }
        }
        S1_BAR();
    }
    {
        const int ib = w >> 1;
#pragma unroll
        for (int vbi = 0; vbi < 2; ++vbi) { const int vb = 2 * (w & 1) + vbi; f32x4_t acc = (f32x4_t){0.f, 0.f, 0.f, 0.f};
            acc = mma(ldfrag(AAK, 16 * ib + l15, 8 * q), ldfrag(VT, 16 * vb + l15, 8 * q), acc); acc = mma(ldfrag(AAK, 16 * ib + l15, 8 * q + 32), ldfrag(VT, 16 * vb + l15, 8 * q + 32), acc);
#pragma unroll
            for (int r = 0; r < 4; ++r) RHS[(16 * ib + 4 * q + r) * PRHS + 64 + 16 * vb + l15] = acc[r]; }
        S1_BAR();
    }
    {
        float x[64];
        if (tid < 128) {
#pragma unroll
            for (int i = 0; i < 64; ++i) { float s = RHS[i * PRHS + tid];
#pragma unroll
                for (int s4 = 0; s4 < (i + 3) / 4; ++s4) { const f32x4_t av = *(const LAS f32x4_t*)(AAB + i * PAB + 4 * s4);
#pragma unroll
                    for (int e = 0; e < 4; ++e) if (4 * s4 + e < i) s += av[e] * x[4 * s4 + e]; }
                x[i] = s; }
        }
        S1_BAR();
        if (tid < 128) {
#pragma unroll
            for (int m = 0; m < 8; ++m) { v4u p; p.x = pk2(x[8 * m], x[8 * m + 1]); p.y = pk2(x[8 * m + 2], x[8 * m + 3]); p.z = pk2(x[8 * m + 4], x[8 * m + 5]); p.w = pk2(x[8 * m + 6], x[8 * m + 7]);
                *(LAS v4u*)(XT + tid * PB + 8 * m) = p; }
        }
        S1_BAR();
    }
    {
        const int mat = w >> 1, half = w & 1;
#pragma unroll
        for (int tt = 0; tt < 8; ++tt) { const int tb = 8 * half + tt, rb = tb >> 2, cb = tb & 3;
            f32x4_t acc = (f32x4_t){0.f, 0.f, 0.f, 0.f};
            const LAS bf16* Am = (mat < 2) ? BTT : ARB; const int xrow = ((mat & 1) ? 64 : 0) + 16 * cb + l15;
            acc = mma(ldfrag(Am, 16 * rb + l15, 8 * q), ldfrag(XT, xrow, 8 * q), acc); acc = mma(ldfrag(Am, 16 * rb + l15, 8 * q + 32), ldfrag(XT, xrow, 8 * q + 32), acc);
            if (mat & 1) { const LAS bf16* A2 = (mat == 1) ? KTT : ARK;
                acc = mma(ldfrag(A2, 16 * rb + l15, 8 * q), ldfrag(VT, 16 * cb + l15, 8 * q), acc); acc = mma(ldfrag(A2, 16 * rb + l15, 8 * q + 32), ldfrag(VT, 16 * cb + l15, 8 * q + 32), acc); }
            const int row0 = 16 * rb + 4 * q, col = 16 * cb + l15;
            if (mat == 0) {
#pragma unroll
                for (int r = 0; r < 4; ++r) A.P[(size_t)u * 4096 + (row0 + r) * 64 + col] = (bf16)f2bf(acc[r] * GCL[row0 + r]);
            } else if (mat == 1) {
                uint2 o; o.x = pk2(acc[0] * GCL[row0], acc[1] * GCL[row0 + 1]); o.y = pk2(acc[2] * GCL[row0 + 2], acc[3] * GCL[row0 + 3]);
                *(uint2*)(A.Q + (size_t)u * 4096 + ((cb * 4 + rb) * 64 + lane) * 4) = o;
            } else if (mat == 2) {
#pragma unroll
                for (int r = 0; r < 4; ++r) A.RP[(size_t)u * 4096 + (row0 + r) * 64 + col] = (bf16)f2bf(acc[r] + bf2f(RT[(row0 + r) * PB + col]));
            } else {
                uint2 o; o.x = pk2(acc[0], acc[1]); o.y = pk2(acc[2], acc[3]);
                *(uint2*)(A.YL + (size_t)u * 4096 + ((cb * 4 + rb) * 64 + lane) * 4) = o;
            }
        }
        if (tid < 64) A.GC[(size_t)u * 64 + tid] = GCL[tid];
        S1_BAR();
    }
}
__device__ __forceinline__ void s1_phase(LAS unsigned char* lds, const Args& A, int vcu, int G, int wv) {
    asm volatile("" : "+s"(vcu));
    for (int u = vcu; u < 2 * 16 * NCH; u += G) { const int c = u & (NCH - 1), dh = u >> 7; s1_unit(lds, A, dh >> 4, dh & 15, c, wv); }
}

struct Ops { bf16x8 pf[4][2]; uint2 q[4]; f32x4_t gc[4]; };
__device__ __forceinline__ bf16x8 ld_perm(const bf16* p) { const uint2 lo = *(const uint2*)p, hi = *(const uint2*)(p + 16); const v4u v = {lo.x, lo.y, hi.x, hi.y}; return __builtin_bit_cast(bf16x8, v); }
__device__ __forceinline__ void s2_load(Ops& o, const Args& A, int dh, int vblk, int c, int lane) {
    const int u = dh * NCH + c, l15 = lane & 15, q = lane >> 4;
    const bf16* Pu = A.P + (size_t)u * 4096;
#pragma unroll
    for (int rb = 0; rb < 4; ++rb)
#pragma unroll
        for (int ks = 0; ks < 2; ++ks) o.pf[rb][ks] = ld_perm(Pu + (16 * rb + l15) * 64 + 32 * ks + 4 * q);
#pragma unroll
    for (int rb = 0; rb < 4; ++rb) { o.q[rb] = *(const uint2*)(A.Q + (size_t)u * 4096 + ((vblk * 4 + rb) * 64 + lane) * 4); o.gc[rb] = *(const f32x4_t*)(A.GC + (size_t)u * 64 + 16 * rb + 4 * q); }
}
__device__ __forceinline__ unsigned cvtpk(float lo, float hi) { unsigned r; asm volatile("v_cvt_pk_bf16_f32 %0, %1, %2" : "=v"(r) : "v"(lo), "v"(hi)); return r; }
__device__ __forceinline__ void s2_step(const Ops& o, f32x4_t (&T)[4], const Args& A, int dh, int vblk, int c, int lane) {
    const int u = dh * NCH + c, l15 = lane & 15, q = lane >> 4;
    unsigned tw[4][2];
#pragma unroll
    for (int rb = 0; rb < 4; ++rb) { tw[rb][0] = cvtpk(T[rb][0], T[rb][1]); tw[rb][1] = cvtpk(T[rb][2], T[rb][3]);
        uint2 st; st.x = tw[rb][0]; st.y = tw[rb][1]; *(uint2*)(A.TT + (size_t)u * 4096 + (16 * vblk + l15) * 64 + 16 * rb + 4 * q) = st; }
    bf16x8 tb[2];
#pragma unroll
    for (int ks = 0; ks < 2; ++ks) { const v4u v = {tw[2 * ks][0], tw[2 * ks][1], tw[2 * ks + 1][0], tw[2 * ks + 1][1]}; tb[ks] = __builtin_bit_cast(bf16x8, v); }
#pragma unroll
    for (int rb = 0; rb < 4; ++rb) { const f32x4_t qf = {bf2f(o.q[rb].x & 0xffffu), bf2f(o.q[rb].x >> 16), bf2f(o.q[rb].y & 0xffffu), bf2f(o.q[rb].y >> 16)};
        f32x4_t tn = o.gc[rb] * T[rb] + qf; tn = mma(o.pf[rb][0], tb[0], tn); tn = mma(o.pf[rb][1], tb[1], tn); T[rb] = tn; }
}
__device__ __forceinline__ void s2_phase(const Args& A, int wg, int wave, int lane) {
    asm volatile("" : "+v"(lane), "+s"(wg), "+s"(wave));
    if (wg >= 32 || wave >= 4) return;
    const int dh = wg, d = wg >> 4, vblk = wave;
    f32x4_t T[4];
#pragma unroll
    for (int rb = 0; rb < 4; ++rb) T[rb] = (f32x4_t){0.f, 0.f, 0.f, 0.f};
    Ops oa, ob, oc;
#define CI(k) (d ? NCH - 1 - (k) : (k))
    s2_load(oa, A, dh, vblk, CI(0), lane); s2_load(ob, A, dh, vblk, CI(1), lane);
    int cc = 0;
    for (; cc + 3 <= NCH - 2; cc += 3) {
        s2_load(oc, A, dh, vblk, CI(cc + 2), lane); s2_step(oa, T, A, dh, vblk, CI(cc), lane);
        s2_load(oa, A, dh, vblk, CI(cc + 3), lane); s2_step(ob, T, A, dh, vblk, CI(cc + 1), lane);
        s2_load(ob, A, dh, vblk, CI(cc + 4), lane); s2_step(oc, T, A, dh, vblk, CI(cc + 2), lane);
    }
    s2_step(oa, T, A, dh, vblk, CI(cc), lane); s2_step(ob, T, A, dh, vblk, CI(cc + 1), lane);
#undef CI
}

constexpr int PYS = 65;
__device__ __forceinline__ void s3_post_phase(LAS unsigned char* lds, const Args& A, int vcu, int G, int wv, const bf16* V, const bf16* Gt, const float* BONUS, const float* ln_w, const float* ln_b, bf16* YCAT) {
    int lane_l = lane_id(); asm volatile("" : "+v"(lane_l), "+s"(wv), "+s"(vcu));
    const int lane = lane_l, w = __builtin_amdgcn_readfirstlane(wv), tid = w * 64 + lane, l15 = lane & 15, q = lane >> 4; (void)tid;
    LAS float* YS = (LAS float*)lds;
    for (int un = vcu; un < 16 * NCH; un += G) {
        const int c = un & (NCH - 1), h = un >> 7;
        { const int d = w >> 2, ib = w & 3, u = (d * 16 + h) * NCH + c;
          const bf16* Ru = A.RP + (size_t)u * 4096; const bf16* Tu = A.TT + (size_t)u * 4096;
          const bf16x8 a0 = *(const bf16x8*)(Ru + (16 * ib + l15) * 64 + 8 * q), a1 = *(const bf16x8*)(Ru + (16 * ib + l15) * 64 + 8 * q + 32);
#pragma unroll
          for (int vb = 0; vb < 4; ++vb) {
              const uint2 yl = *(const uint2*)(A.YL + (size_t)u * 4096 + ((vb * 4 + ib) * 64 + lane) * 4);
              f32x4_t acc = {bf2f(yl.x & 0xffffu), bf2f(yl.x >> 16), bf2f(yl.y & 0xffffu), bf2f(yl.y >> 16)};
              acc = mma(a0, *(const bf16x8*)(Tu + (16 * vb + l15) * 64 + 8 * q), acc); acc = mma(a1, *(const bf16x8*)(Tu + (16 * vb + l15) * 64 + 8 * q + 32), acc);
#pragma unroll
              for (int r = 0; r < 4; ++r) { const int i = 16 * ib + 4 * q + r, tok = d ? 63 - i : i; YS[(d * 64 + tok) * PYS + 16 * vb + l15] = acc[r]; }
          } }
        asm volatile("s_waitcnt lgkmcnt(0)" ::: "memory"); __builtin_amdgcn_s_barrier(); asm volatile("" ::: "memory");
#pragma unroll
        for (int k = 0; k < 8; ++k) { const int tok = 8 * w + k, t = 64 * c + tok, ch = h * 64 + lane; const size_t o = (size_t)t * 1024 + ch;
            const float y = YS[tok * PYS + lane] + YS[(64 + tok) * PYS + lane];
            const float mu = wave_sum(y) * (1.f / 64.f); const float dlt = y - mu;
            const float var = wave_sum(dlt * dlt) * (1.f / 64.f);
            float yn = dlt * rsqrtf(var + GN_EPS) * ln_w[ch] + ln_b[ch];
            yn += BONUS[t * 16 + h] * bf2f(V[o]); yn *= bf2f(Gt[o]);
            YCAT[(size_t)t * 2048 + ch] = (bf16)f2bf(yn); }
        asm volatile("s_waitcnt lgkmcnt(0)" ::: "memory"); __builtin_amdgcn_s_barrier(); asm volatile("" ::: "memory");
    }
}
#undef S1_BAR
}


constexpr int NWAVES = 8;
constexpr size_t MiB = 1u << 20;
constexpr size_t WS_CTL = 0, CTL_ZERO_BYTES = 1 * MiB;
constexpr size_t WS_W = 1 * MiB, WL_STRIDE = 122 * MiB;
constexpr size_t OFF_WIN = 0, OFF_WCAT = 36 * MiB, OFF_WO = 44 * MiB, OFF_WXQ = 52 * MiB, OFF_WXO = 54 * MiB, OFF_WGU = 56 * MiB, OFF_WD = 100 * MiB;
constexpr size_t WS_WXKV = WS_W + 4 * WL_STRIDE;
constexpr size_t WS_Z = 505 * MiB;
constexpr size_t WS_HID = WS_Z;
constexpr size_t WS_HB = 649 * MiB;
constexpr size_t WS_MERGED = WS_HB;
constexpr size_t WS_RW = 681 * MiB;
constexpr size_t WS_LW = 825 * MiB;
constexpr size_t WS_YCAT = WS_LW;
constexpr size_t WS_TMP = 889 * MiB;
constexpr size_t WS_YF = WS_TMP;
constexpr size_t WS_QB = 953 * MiB, WS_KB = 969 * MiB, WS_VB = 973 * MiB, WS_XQ = 977 * MiB, WS_XO = 985 * MiB, WS_MKVF = 993 * MiB, WS_MEMN = 1001 * MiB,
                 WS_ROPE = 1005 * MiB, WS_BONUS = 1009 * MiB, WS_S1P = 1010 * MiB, WS_S1R = 1042 * MiB, WS_S1Q = 1074 * MiB, WS_GC = 1106 * MiB, WS_END = 1107 * MiB;
constexpr int CW_TMO = 0, CW_CODE = 1, CW_BAR = 4096;
constexpr int RING_OFF = 0, RING_BYTES = 131072, LDS_BYTES = 163840, LDSCTL_OFF = LDS_BYTES - 512, MISC_OFF = LDSCTL_OFF + 320;
static_assert(scan::S1_LDS <= LDSCTL_OFF && attn_body::ATTN_LDS_BYTES <= RING_BYTES, "LDS map");

typedef GAS unsigned gu32;
#define RLX_AGENT __ATOMIC_RELAXED, __HIP_MEMORY_SCOPE_AGENT
#define LDS_WAIT() asm volatile("s_waitcnt lgkmcnt(0)" ::: "memory")
#define VM_WAIT() asm volatile("s_waitcnt vmcnt(0)" ::: "memory")

#define XB_TMO      128
#define XB_XCNT(j)  (256  + 64 * (j))
#define XB_XSUB(j)  (1280 + 64 * (j))
#define XB_XGEN(j)  (2304 + 64 * (j))
#define XB_TOP      3328
#define XB_TOPGEN   3392
#define XCD_BAR_WORDS 3456
#define XB_SPIN_CAP (1u << 18)

__device__ __forceinline__ unsigned xb_ld(unsigned* p)              { return __hip_atomic_load(p, __ATOMIC_RELAXED, __HIP_MEMORY_SCOPE_AGENT); }
__device__ __forceinline__ unsigned xb_add(unsigned* p, unsigned v) { return __hip_atomic_fetch_add(p, v, __ATOMIC_RELAXED, __HIP_MEMORY_SCOPE_AGENT); }
__device__ __forceinline__ unsigned xb_xcc_id() { return (unsigned)__builtin_amdgcn_s_getreg((3 << 11) | 20) & 0xFu; }
#define XB_SPIN(cond, bar) do { unsigned _sp = 0; while (cond) { __builtin_amdgcn_s_sleep(1); \
    if ((++_sp & 255u) == 0u) { if (xb_ld(&(bar)[XB_TMO])) break; if (_sp > XB_SPIN_CAP) { atomicAdd(&(bar)[XB_TMO], 1u); break; } } } } while (0)

struct XcdBarrier {
    unsigned* bar; unsigned x; unsigned w;
    volatile LAS unsigned* st;
};

__device__ __forceinline__ XcdBarrier xcd_barrier_post(unsigned* bar, volatile LAS unsigned* st, unsigned wave) {
    XcdBarrier b; b.bar = bar; b.x = xb_xcc_id(); b.st = st; b.w = wave;
    if (wave == 0u && lane_id() == 0) (void)xb_add(&bar[XB_XCNT(b.x)], 1u);
    return b;
}
__device__ __forceinline__ void xcd_barrier_complete(unsigned* bar, unsigned x, unsigned& nloc, unsigned& nx) {
    const unsigned G = gridDim.x * gridDim.y * gridDim.z;
    unsigned sum, cnt, mine, sp = 0u;
    for (;;) {
        sum = 0u; cnt = 0u; mine = 0u;
#pragma unroll
        for (unsigned j = 0; j < 16; ++j) { const unsigned c = xb_ld(&bar[XB_XCNT(j)]); sum += c; cnt += (c > 0u) ? 1u : 0u; mine = (j == x) ? c : mine; }
        if (sum == G) break;
        __builtin_amdgcn_s_sleep(1);
        if ((++sp & 255u) == 0u) { if (xb_ld(&bar[XB_TMO])) break; if (sp > XB_SPIN_CAP) { atomicAdd(&bar[XB_TMO], 1u); break; } }
    }
    nloc = mine > 0u ? mine : 1u; nx = cnt > 0u ? cnt : 1u;
}

__device__ __forceinline__ void xcd_barrier(const XcdBarrier& b) {
    asm volatile("s_waitcnt vmcnt(0)" ::: "memory");
    __syncthreads();
    if (b.w == 0u && lane_id() == 0) {
        unsigned* bar = b.bar;
        __builtin_amdgcn_s_waitcnt(0);
        unsigned nloc = b.st[0], nx = b.st[1];
        if (nloc == 0u) { xcd_barrier_complete(bar, b.x, nloc, nx); b.st[0] = nloc; b.st[1] = nx; }
        const unsigned old = xb_add(&bar[XB_XSUB(b.x)], 1u);
        const unsigned gen = old / nloc;
        if (old + 1u == (gen + 1u) * nloc) {
            __builtin_amdgcn_fence(__ATOMIC_RELEASE, "agent");
            asm volatile("s_waitcnt vmcnt(0)" ::: "memory");
            const unsigned og = xb_add(&bar[XB_TOP], 1u);
            const unsigned tg = og / nx;
            if (og + 1u == (tg + 1u) * nx) xb_add(&bar[XB_TOPGEN], 1u);
            else XB_SPIN(xb_ld(&bar[XB_TOPGEN]) == tg, bar);
            __builtin_amdgcn_fence(__ATOMIC_ACQUIRE, "agent");
            xb_add(&bar[XB_XGEN(b.x)], 1u);
            asm volatile("s_waitcnt vmcnt(0)" ::: "memory");
        } else {
            XB_SPIN(xb_ld(&bar[XB_XGEN(b.x)]) == gen, bar);
            __builtin_amdgcn_fence(__ATOMIC_ACQUIRE, "agent");
            asm volatile("s_waitcnt vmcnt(0)" ::: "memory");
        }
    }
    __syncthreads();
}


#ifndef MK_ONE_LAUNCH
#define MK_ONE_LAUNCH 1
#endif
constexpr int NS = 15;
enum Site { ST_INPROJ = 0, ST_PREP, ST_S1, ST_S2, ST_ATTN, ST_MERGE, ST_WO, ST_NORM1, ST_XQ, ST_XATTN, ST_XO, ST_NORM2, ST_UP, ST_DOWN, ST_NORM3 };
constexpr int NPHASE = 2 + NL * NS;

struct MKArgs { const float* in[36]; float* out; unsigned char* ws; int ph_lo, ph_hi; };

struct Frame {
    LAS unsigned char* lds; volatile LAS unsigned* MISC; gu32* ctl;
    int tid, lane, wave, vcu, G;
};

__device__ __forceinline__ void transpose_item(const float* W, int N, bf16* WT, int ldk, int k0, int n0, int drow0, int dk0, LAS float* scr, int lane) {
#pragma unroll 8
    for (int i = 0; i < 32; ++i) { const int kk = 2 * i + (lane >> 5); scr[kk * 33 + (lane & 31)] = W[(size_t)(k0 + kk) * N + n0 + (lane & 31)]; }
    LDS_WAIT(); asm volatile("" ::: "memory");
    const int c = lane & 7;
#pragma unroll
    for (int j = 0; j < 4; ++j) { const int n = (lane >> 3) + 8 * j; const LAS float* s = scr + (8 * c) * 33 + n;
        v4u o; o.x = pk2(s[0 * 33], s[1 * 33]); o.y = pk2(s[2 * 33], s[3 * 33]); o.z = pk2(s[4 * 33], s[5 * 33]); o.w = pk2(s[6 * 33], s[7 * 33]);
        *(GAS v4u*)(WT + (size_t)(drow0 + n) * ldk + dk0 + k0 + 8 * c) = o; }
    LDS_WAIT(); asm volatile("" ::: "memory");
}
__device__ __forceinline__ void rms_row_to_bf16(int lane, const float* xrow, const float* gain, bf16* orow, float* cp) {
    const f32x4* xr = (const f32x4*)xrow + lane;
    f32x4 v[8]; float ss = 0.f;
#pragma unroll
    for (int j = 0; j < 8; ++j) { v[j] = xr[64 * j]; ss += (v[j].x * v[j].x + v[j].y * v[j].y) + (v[j].z * v[j].z + v[j].w * v[j].w); }
    if (cp) {
#pragma unroll
        for (int j = 0; j < 8; ++j) ((f32x4*)cp)[lane + 64 * j] = v[j];
    }
    const float r = rsqrtf(wave_sum(ss) * (1.f / D) + EPS);
    unsigned long long* o8 = (unsigned long long*)orow + lane;
#pragma unroll
    for (int j = 0; j < 8; ++j) { const f32x4 g = ((const f32x4*)gain)[lane + 64 * j];
        o8[64 * j] = (unsigned long long)pk2(v[j].x * r * g.x, v[j].y * r * g.y) | ((unsigned long long)pk2(v[j].z * r * g.z, v[j].w * r * g.w) << 32); }
}

constexpr int I_WIN = 32 * 285, I_RWO = 16 * 64, I_ATO = 16 * 64, I_WO = 32 * 64, I_XQ = 32 * 16, I_XKV = 32 * 32, I_XO = 8 * 64, I_WG = 32 * 176, I_WU = 32 * 176, I_WD = 88 * 64;
constexpr int I_LAYER = I_WIN + I_RWO + I_ATO + I_WO + I_XQ + I_XKV + I_XO + I_WG + I_WU + I_WD;

__device__ __forceinline__ void p0_prologue(Frame& F, const MKArgs& a) {
    LAS float* scr = (LAS float*)(F.lds + RING_OFF + F.wave * 16384);
    unsigned char* ws = a.ws;
    const int gw = F.vcu * NWAVES + F.wave, NGW = F.G * NWAVES;
    for (int it = gw; it < NL * I_LAYER; it += NGW) {
        const int l = it / I_LAYER; int r = it % I_LAYER;
        unsigned char* wl = ws + WS_W + (size_t)l * WL_STRIDE;
        if (r < I_WIN) { const int kb = r / 285, nb = r % 285; transpose_item(a.in[9] + (size_t)l * D * INC, INC, (bf16*)(wl + OFF_WIN), 2048, 64 * kb, 32 * nb, 32 * nb, 0, scr, F.lane); continue; } r -= I_WIN;
        if (r < I_RWO) { const int kb = r / 64, nb = r % 64; transpose_item(a.in[25] + (size_t)l * 1024 * D, D, (bf16*)(wl + OFF_WCAT), 2048, 64 * kb, 32 * nb, 32 * nb, 0, scr, F.lane); continue; } r -= I_RWO;
        if (r < I_ATO) { const int kb = r / 64, nb = r % 64; transpose_item(a.in[28] + (size_t)l * 1024 * D, D, (bf16*)(wl + OFF_WCAT), 2048, 64 * kb, 32 * nb, 32 * nb, 1024, scr, F.lane); continue; } r -= I_ATO;
        if (r < I_WO) { const int kb = r / 64, nb = r % 64; transpose_item(a.in[29] + (size_t)l * D * D, D, (bf16*)(wl + OFF_WO), 2048, 64 * kb, 32 * nb, 32 * nb, 0, scr, F.lane); continue; } r -= I_WO;
        if (r < I_XQ) { const int kb = r / 16, nb = r % 16; transpose_item(a.in[30] + (size_t)l * D * XW, XW, (bf16*)(wl + OFF_WXQ), 2048, 64 * kb, 32 * nb, 32 * nb, 0, scr, F.lane); continue; } r -= I_XQ;
        if (r < I_XKV) { const int kb = r / 32, nb = r % 32; transpose_item(a.in[31] + (size_t)l * D * 1024, 1024, (bf16*)(ws + WS_WXKV), 2048, 64 * kb, 32 * nb, l * 1024 + 32 * nb, 0, scr, F.lane); continue; } r -= I_XKV;
        if (r < I_XO) { const int kb = r / 64, nb = r % 64; transpose_item(a.in[32] + (size_t)l * XW * D, D, (bf16*)(wl + OFF_WXO), 512, 64 * kb, 32 * nb, 32 * nb, 0, scr, F.lane); continue; } r -= I_XO;
        if (r < I_WG) { const int kb = r / 176, nb = r % 176, n0 = 32 * nb; transpose_item(a.in[33] + (size_t)l * D * DFF, DFF, (bf16*)(wl + OFF_WGU), 2048, 64 * kb, n0, 256 * (n0 >> 7) + (n0 & 127), 0, scr, F.lane); continue; } r -= I_WG;
        if (r < I_WU) { const int kb = r / 176, nb = r % 176, n0 = 32 * nb; transpose_item(a.in[34] + (size_t)l * D * DFF, DFF, (bf16*)(wl + OFF_WGU), 2048, 64 * kb, n0, 256 * (n0 >> 7) + 128 + (n0 & 127), 0, scr, F.lane); continue; } r -= I_WU;
        { const int kb = r / 64, nb = r % 64; transpose_item(a.in[35] + (size_t)l * DFF * D, D, (bf16*)(wl + OFF_WD), 5632, 64 * kb, 32 * nb, 32 * nb, 0, scr, F.lane); }
    }
    { const int gt = F.vcu * (NWAVES * 64) + F.tid, NGT = F.G * NWAVES * 64;
      for (int i = gt; i < NL * 96 * 256; i += NGT) { const int l = i / (96 * 256), q = i % (96 * 256);
          *(GAS v4u*)(ws + WS_W + (size_t)l * WL_STRIDE + OFF_WIN + (size_t)9120 * 2048 * 2 + (size_t)q * 16) = (v4u){0u, 0u, 0u, 0u}; }
      float* RC = (float*)(ws + WS_ROPE); float* RS = RC + S * 64;
      for (int i = gt; i < S * 64; i += NGT) { const int t = i >> 6, j = i & 63, f = j & 15;
          const float inv = powf(10000.0f, -(float)f / 16.0f); const float pos = (j < 32) ? (float)(t >> 6) : (float)(t & 63); const float ang = pos * inv;
          RC[i] = cosf(ang); RS[i] = sinf(ang); } }
    for (int m = gw; m < NL * NMEM; m += NGW) { const int l = m >> 8, key = m & 255;
        rms_row_to_bf16(F.lane, a.in[1] + (size_t)key * D, a.in[8] + (size_t)l * D, (bf16*)(ws + WS_MEMN) + (size_t)m * D, nullptr); }
    for (int m = gw; m < S; m += NGW) rms_row_to_bf16(F.lane, a.in[0] + (size_t)m * D, a.in[2], (bf16*)(ws + WS_HB) + (size_t)m * D, a.out + (size_t)m * D);
}

__device__ __forceinline__ const float* arg_in(const MKArgs& a, int k) { asm volatile("" : "+s"(k)); return a.in[k]; }
__device__ __forceinline__ unsigned char* launder(unsigned char* p) { asm volatile("" : "+s"(p)); return p; }
struct RwPtrs { bf16 *Rb, *Vv, *KKb, *KD0, *KD1, *B0, *B1, *Gb, *VFIRST, *Vcur; float *LW0, *LW1; };
__device__ __forceinline__ RwPtrs rw_ptrs(unsigned char* ws, int l) {
    RwPtrs r; bf16* RWB = (bf16*)(ws + WS_RW); const size_t RWS = (size_t)8 * MiB;
    r.Rb = RWB; r.Vv = RWB + RWS; r.KKb = RWB + 2 * RWS; r.KD0 = RWB + 3 * RWS; r.KD1 = RWB + 4 * RWS; r.B0 = RWB + 5 * RWS; r.B1 = RWB + 6 * RWS; r.Gb = RWB + 7 * RWS; r.VFIRST = RWB + 8 * RWS;
    r.Vcur = (l == 0) ? r.VFIRST : r.Vv; r.LW0 = (float*)(ws + WS_LW); r.LW1 = r.LW0 + (size_t)8 * MiB; return r;
}
__device__ __forceinline__ scan::Args scan_args(unsigned char* ws, int l) {
    const RwPtrs r = rw_ptrs(ws, l);
    return scan::Args{r.Rb, r.Vcur, r.KKb, r.KD0, r.KD1, r.B0, r.B1, r.LW0, r.LW1, (bf16*)(ws + WS_S1P), (bf16*)(ws + WS_S1R), (bf16*)(ws + WS_S1Q), (bf16*)(ws + WS_YF), (bf16*)(ws + WS_YF + 32 * MiB), (float*)(ws + WS_GC)};
}

__global__ void __launch_bounds__(NWAVES * 64, 2) mk_fwd(MKArgs a) {
    extern __shared__ __attribute__((aligned(16))) unsigned char lds[];
    Frame F;
    F.lds = (LAS unsigned char*)lds;
    F.MISC = (volatile LAS unsigned*)(F.lds + MISC_OFF);
    F.wave = __builtin_amdgcn_readfirstlane((int)threadIdx.x >> 6); F.lane = lane_id(); F.tid = F.wave * 64 + F.lane;
    F.G = gridDim.x; { const int bx = blockIdx.x; F.vcu = (F.G % 8 == 0) ? (bx % 8) * (F.G / 8) + bx / 8 : bx; }
    unsigned char* ws = a.ws;
    F.ctl = (gu32*)(ws + WS_CTL);
    for (int u = F.tid; u < (LDS_BYTES - LDSCTL_OFF) / 4; u += NWAVES * 64) ((LAS unsigned*)(F.lds + LDSCTL_OFF))[u] = 0u;
    __syncthreads();
    XcdBarrier bar = xcd_barrier_post((unsigned*)(F.ctl + CW_BAR), F.MISC + 8, (unsigned)F.wave);
    const int lo = a.ph_lo, hi = a.ph_hi;
#ifndef PH_MASK
#define PH_MASK 0xFFFFFFFFu
#endif
#define IN(k) (lo <= (k) && (k) < hi)
#define INS(s) (((PH_MASK >> (s)) & 1u) && IN(pb + (s)))
#define SEAM(k) do { if ((k) + 1 < hi) { XcdBarrier b2_ = bar; asm volatile("" : "+s"(b2_.bar)); xcd_barrier(b2_); } } while (0)

    if (IN(0)) { p0_prologue(F, a); SEAM(0); }
    if (IN(1)) {
        pg8::Gemm g{(const bf16*)(ws + WS_MEMN), (const bf16*)(ws + WS_WXKV), NL * NMEM, NL * 1024, D}; pg8::StaticOrder So; So.init(NL * NMEM, NL * 1024, F.G, (int)blockIdx.x);
        pg8::EpiBf16S E{(bf16*)(ws + WS_MKVF), NL * 1024, 1.f};
        pg8::gemm_phase<pg8::EpiBf16S, pg8::StaticOrder, false, true>(F.lds + RING_OFF, g, So, E, F.wave);
        SEAM(1);
    }
    const int gw = F.vcu * NWAVES + F.wave, NGW = F.G * NWAVES;
    for (int l = 0; l < NL; ++l) {
        const int pb = 2 + l * NS;
        if (pb + NS <= lo || pb >= hi) continue;
        if (INS(ST_INPROJ)) {
            unsigned char* ws = launder(a.ws); unsigned char* wl = ws + WS_W + (size_t)l * WL_STRIDE; (void)wl;
            pg8::Gemm g{(const bf16*)(ws + WS_HB), (const bf16*)(wl + OFF_WIN), S, ZP, D}; pg8::StaticOrder So; So.init(S, ZP, F.G, (int)blockIdx.x);
            pg8::EpiBf16S E{(bf16*)(ws + WS_Z), ZP, 1.f};
            pg8::gemm_phase<pg8::EpiBf16S, pg8::StaticOrder, true, true>(F.lds + RING_OFF, g, So, E, F.wave);
            SEAM(pb + ST_INPROJ);
        }
        if (INS(ST_PREP)) {
            unsigned char* ws = launder(a.ws); unsigned char* wl = ws + WS_W + (size_t)l * WL_STRIDE; (void)wl;
            ph_prep_attn(gw, NGW, F.lane, (const bf16*)(ws + WS_Z), arg_in(a, 26) + l * 64, arg_in(a, 27) + l * 64, (const float*)(ws + WS_ROPE), (const float*)(ws + WS_ROPE) + S * 64,
                         (bf16*)(ws + WS_QB), (bf16*)(ws + WS_KB), (bf16*)(ws + WS_VB));
            PrepArgs p; p.Z = (const bf16*)(ws + WS_Z); p.mu_p = arg_in(a, 10) + (size_t)l * RWC; p.mu_n = arg_in(a, 11) + (size_t)l * RWC; p.w0 = arg_in(a, 12) + (size_t)l * 2048; p.w_up = arg_in(a, 13) + (size_t)l * 2 * 64 * 1024;
            p.a0 = arg_in(a, 14) + (size_t)l * 2048; p.a_up = arg_in(a, 15) + (size_t)l * 2 * 64 * 1024; p.g_up = arg_in(a, 16) + (size_t)l * 160 * 1024;
            const int lm = l > 0 ? l - 1 : 0;
            p.v0 = arg_in(a, 17) + (size_t)lm * 1024; p.v_down = arg_in(a, 18) + (size_t)lm * 1024 * 32; p.v_up = arg_in(a, 19) + (size_t)lm * 32 * 1024;
            const RwPtrs rp = rw_ptrs(ws, l);
            p.k_k = arg_in(a, 20) + (size_t)l * 1024; p.k_a = arg_in(a, 21) + (size_t)l * 1024; p.r_k = arg_in(a, 22) + (size_t)l * 1024; p.VFIRST = rp.VFIRST;
            p.R = rp.Rb; p.V = rp.Vcur; p.KK = rp.KKb; p.KD0 = rp.KD0; p.KD1 = rp.KD1; p.B0 = rp.B0; p.B1 = rp.B1; p.G = rp.Gb; p.LW0 = rp.LW0; p.LW1 = rp.LW1; p.BONUS = (float*)(ws + WS_BONUS); p.layer = l;
            ph_prep_rwkv(F.lds, p, F.vcu, F.G, F.wave);
            SEAM(pb + ST_PREP);
        }
        if (INS(ST_S1)) { const scan::Args sa = scan_args(launder(a.ws), l); scan::s1_phase(F.lds, sa, F.vcu, F.G, F.wave); SEAM(pb + ST_S1); }
        if (INS(ST_S2)) { const scan::Args sa = scan_args(launder(a.ws), l); scan::s2_phase(sa, (int)blockIdx.x, F.wave, F.lane); SEAM(pb + ST_S2); }
        if (INS(ST_ATTN)) {
            unsigned char* ws = launder(a.ws); unsigned char* wl = ws + WS_W + (size_t)l * WL_STRIDE; (void)wl;
            const scan::Args sa = scan_args(ws, l); const RwPtrs rp = rw_ptrs(ws, l);
            scan::s3_post_phase(F.lds, sa, F.vcu, F.G, F.wave, rp.Vcur, rp.Gb, (const float*)(ws + WS_BONUS), arg_in(a, 23) + (size_t)l * 1024, arg_in(a, 24) + (size_t)l * 1024, (bf16*)(ws + WS_YCAT));
            __syncthreads();
            const attn_body::AttnTensors AT{(const attn_body::bf16*)(ws + WS_QB), (const attn_body::bf16*)(ws + WS_KB), (const attn_body::bf16*)(ws + WS_VB), (attn_body::bf16*)(ws + WS_YCAT) + 1024};
            const attn_body::StaticOrder So((int)F.G, (int)blockIdx.x);
            attn_body::attn_phase<attn_body::StaticOrder>((char*)lds + RING_OFF, AT, So, F.wave);
            SEAM(pb + ST_ATTN);
        }
        if (INS(ST_MERGE)) {
            unsigned char* ws = launder(a.ws); unsigned char* wl = ws + WS_W + (size_t)l * WL_STRIDE; (void)wl;
            pg8::Gemm g{(const bf16*)(ws + WS_YCAT), (const bf16*)(wl + OFF_WCAT), S, D, D}; pg8::StaticOrder So; So.init(S, D, F.G, (int)blockIdx.x);
            pg8::EpiMerge E{(const bf16*)(ws + WS_Z), (bf16*)(ws + WS_MERGED)};
            pg8::gemm_phase<pg8::EpiMerge, pg8::StaticOrder, false, true>(F.lds + RING_OFF, g, So, E, F.wave);
            SEAM(pb + ST_MERGE);
        }
        if (INS(ST_WO)) {
            unsigned char* ws = launder(a.ws); unsigned char* wl = ws + WS_W + (size_t)l * WL_STRIDE; (void)wl;
            pg8::Gemm g{(const bf16*)(ws + WS_MERGED), (const bf16*)(wl + OFF_WO), S, D, D}; pg8::StaticOrder So; So.init(S, D, F.G, (int)blockIdx.x);
            pg8::EpiF32 E{(float*)(ws + WS_TMP), D};
            pg8::gemm_phase<pg8::EpiF32, pg8::StaticOrder, false, true>(F.lds + RING_OFF, g, So, E, F.wave);
            SEAM(pb + ST_WO);
        }
        if (INS(ST_NORM1)) { unsigned char* ws = launder(a.ws); ph_norm(gw, NGW, F.lane, a.out, (const float*)(ws + WS_TMP), arg_in(a, 3) + (size_t)l * D, arg_in(a, 4) + (size_t)l * D, (bf16*)(ws + WS_HB)); SEAM(pb + ST_NORM1); }
        if (INS(ST_XQ)) {
            unsigned char* ws = launder(a.ws); unsigned char* wl = ws + WS_W + (size_t)l * WL_STRIDE; (void)wl;
            pg8::Gemm g{(const bf16*)(ws + WS_HB), (const bf16*)(wl + OFF_WXQ), S, XW, D}; pg8::StaticOrder So; So.init(S, XW, F.G, (int)blockIdx.x);
            pg8::EpiBf16S E{(bf16*)(ws + WS_XQ), XW, XQSCALE};
            pg8::gemm_phase<pg8::EpiBf16S, pg8::StaticOrder, false, true>(F.lds + RING_OFF, g, So, E, F.wave);
            SEAM(pb + ST_XQ);
        }
        if (INS(ST_XATTN)) {
            unsigned char* ws = launder(a.ws); unsigned char* wl = ws + WS_W + (size_t)l * WL_STRIDE; (void)wl;
            ph_xattn(gw, NGW, F.lane, (LAS float*)(F.lds + F.wave * 2048), (const bf16*)(ws + WS_XQ), (const bf16*)(ws + WS_MKVF) + (size_t)l * 256 * 4096 + l * 1024, 4096, (bf16*)(ws + WS_XO));
            SEAM(pb + ST_XATTN);
        }
        if (INS(ST_XO)) {
            unsigned char* ws = launder(a.ws); unsigned char* wl = ws + WS_W + (size_t)l * WL_STRIDE; (void)wl;
            pg8::Gemm g{(const bf16*)(ws + WS_XO), (const bf16*)(wl + OFF_WXO), S, D, XW}; pg8::StaticOrder So; So.init(S, D, F.G, (int)blockIdx.x);
            pg8::EpiF32 E{(float*)(ws + WS_TMP), D};
            pg8::gemm_phase<pg8::EpiF32, pg8::StaticOrder, false, true>(F.lds + RING_OFF, g, So, E, F.wave);
            SEAM(pb + ST_XO);
        }
        if (INS(ST_NORM2)) { unsigned char* ws = launder(a.ws); ph_norm(gw, NGW, F.lane, a.out, (const float*)(ws + WS_TMP), arg_in(a, 5) + (size_t)l * D, arg_in(a, 6) + (size_t)l * D, (bf16*)(ws + WS_HB)); SEAM(pb + ST_NORM2); }
        if (INS(ST_UP)) {
            unsigned char* ws = launder(a.ws); unsigned char* wl = ws + WS_W + (size_t)l * WL_STRIDE; (void)wl;
            pg8::Gemm g{(const bf16*)(ws + WS_HB), (const bf16*)(wl + OFF_WGU), S, 2 * DFF, D}; pg8::StaticOrder So; So.init(S, 2 * DFF, F.G, (int)blockIdx.x);
            pg8::EpiSwiGLU E{(bf16*)(ws + WS_HID), DFF};
            pg8::gemm_phase<pg8::EpiSwiGLU, pg8::StaticOrder, true, true>(F.lds + RING_OFF, g, So, E, F.wave);
            SEAM(pb + ST_UP);
        }
        if (INS(ST_DOWN)) {
            unsigned char* ws = launder(a.ws); unsigned char* wl = ws + WS_W + (size_t)l * WL_STRIDE; (void)wl;
            pg8::Gemm g{(const bf16*)(ws + WS_HID), (const bf16*)(wl + OFF_WD), S, D, DFF}; pg8::StaticOrder So; So.init(S, D, F.G, (int)blockIdx.x);
            pg8::EpiF32 E{(float*)(ws + WS_TMP), D};
            pg8::gemm_phase<pg8::EpiF32, pg8::StaticOrder, false, true>(F.lds + RING_OFF, g, So, E, F.wave);
            SEAM(pb + ST_DOWN);
        }
        if (INS(ST_NORM3)) { unsigned char* ws = launder(a.ws); ph_norm(gw, NGW, F.lane, a.out, (const float*)(ws + WS_TMP), arg_in(a, 7) + (size_t)l * D, (l + 1 < NL) ? arg_in(a, 2) + (size_t)(l + 1) * D : (const float*)nullptr, (bf16*)(ws + WS_HB)); SEAM(pb + ST_NORM3); }
    }
#undef IN
#undef INS
#undef SEAM
}

static void mk_launch(hipStream_t st, const MKArgs& base, int lo, int hi) {
    MKArgs a = base; a.ph_lo = lo; a.ph_hi = hi;
    hipLaunchKernelGGL(mk_fwd, dim3(256), dim3(NWAVES * 64), LDS_BYTES, st, a);
}

extern "C" void kernel_launch(void* const* d_in, const int* in_sizes, int n_in, void* d_out, int out_size, void* d_ws, size_t ws_size, hipStream_t stream) {
    static int ready = 0;
    if (ready == 0) {
        ready = -1;
        if (n_in != 36 || ws_size < WS_END) { fprintf(stderr, "kernel_launch: unexpected n_in %d / ws_size %zu (need %zu)\n", n_in, ws_size, (size_t)WS_END); return; }
        int dev = 0, cus = 0;
        if (hipGetDevice(&dev) != hipSuccess || hipDeviceGetAttribute(&cus, hipDeviceAttributeMultiprocessorCount, dev) != hipSuccess) return;
        if (cus < 256) { fprintf(stderr, "kernel_launch: %d CUs < 256\n", cus); return; }
        if (hipFuncSetAttribute((const void*)mk_fwd, hipFuncAttributeMaxDynamicSharedMemorySize, LDS_BYTES) != hipSuccess) { fprintf(stderr, "kernel_launch: hipFuncSetAttribute failed\n"); return; }
        int per_cu = 0;
        if (hipOccupancyMaxActiveBlocksPerMultiprocessor(&per_cu, (const void*)mk_fwd, NWAVES * 64, LDS_BYTES) != hipSuccess || per_cu < 1) { fprintf(stderr, "kernel_launch: occupancy query says %d\n", per_cu); }
        (void)hipGetLastError();
        ready = 1;
    }
    if (ready < 0) return;
    unsigned char* ws = (unsigned char*)d_ws;
    (void)hipMemsetAsync(ws + WS_CTL, 0, CTL_ZERO_BYTES, stream);
    MKArgs base{}; for (int i = 0; i < 36; ++i) base.in[i] = (const float*)d_in[i]; base.out = (float*)d_out; base.ws = ws;
#if MK_ONE_LAUNCH
    mk_launch(stream, base, 0, NPHASE);
#else
    for (int p = 0; p < NPHASE; ++p) mk_launch(stream, base, p, p + 1);
#endif
}
```

```cpp
#include <hip/hip_runtime.h>
#include <cstdio>
#include <cstdint>

typedef unsigned short bf16;
typedef short bf16x8 __attribute__((ext_vector_type(8)));
typedef float f32x4 __attribute__((ext_vector_type(4)));
typedef unsigned v4u __attribute__((ext_vector_type(4)));
#define GAS __attribute__((address_space(1)))
#define LAS __attribute__((address_space(3)))

constexpr int S = 8192, D = 2048, NL = 4;
constexpr int RW = 1024, RWC = 3488, ATQ = 1024, ATKV = 256, INC = 9120, ZP = 9216;
constexpr int DFF = 5632, XW = 512, NMEM = 256;
constexpr int COL_R = 0, COL_K = 1024, COL_V = 2048, COL_WD = 3072, COL_AD = 3200, COL_GD = 3328;
constexpr int COL_AQ = 3488, COL_AK = 4512, COL_AV = 4768, COL_G1 = 5024, COL_G2 = 7072;
constexpr float EPS = 1e-6f, GN_EPS = 64e-5f;
constexpr float QSCALE = 0.125f * 1.4426950408889634f;
constexpr float XQSCALE = 0.08838834764831845f * 1.4426950408889634f;

__device__ __forceinline__ unsigned f2bf(float f) { unsigned u = __builtin_bit_cast(unsigned, f); return (u + 0x7fffu + ((u >> 16) & 1u)) >> 16; }
__device__ __forceinline__ unsigned pk2(float lo, float hi) { return f2bf(lo) | (f2bf(hi) << 16); }
__device__ __forceinline__ float bf2f(unsigned h) { return __builtin_bit_cast(float, h << 16); }
__device__ __forceinline__ int lane_id() { return (int)__builtin_amdgcn_mbcnt_hi(~0u, __builtin_amdgcn_mbcnt_lo(~0u, 0u)); }
__device__ __forceinline__ float shfl_xor_l(float v, int l, int o) { return __builtin_bit_cast(float, __builtin_amdgcn_ds_bpermute((l ^ o) << 2, __builtin_bit_cast(int, v))); }
__device__ __forceinline__ float wave_sum(float v) {
    int l = lane_id(); asm volatile("" : "+v"(l));
#pragma unroll
    for (int o = 1; o < 64; o <<= 1) v += shfl_xor_l(v, l, o);
    return v;
}
__device__ __forceinline__ float sigmoidf_(float x) { return 1.0f / (1.0f + expf(-x)); }

__device__ __forceinline__ float wave_max(float v) {
    int l = lane_id(); asm volatile("" : "+v"(l));
#pragma unroll
    for (int o = 1; o < 64; o <<= 1) v = fmaxf(v, shfl_xor_l(v, l, o));
    return v;
}
__device__ __forceinline__ void ph_norm(int gw, int NGW, int lane, float* x, const float* t, const float* g1, const float* g2, bf16* hb) {
    asm volatile("" : "+v"(lane), "+s"(gw));
    for (int row = gw; row < S; row += NGW) {
        const f32x4* tr = (const f32x4*)(t + (size_t)row * D) + lane; f32x4* xr = (f32x4*)(x + (size_t)row * D) + lane;
        f32x4 v[8]; float ss = 0.f;
#pragma unroll
        for (int j = 0; j < 8; ++j) { v[j] = tr[64 * j]; ss += (v[j].x * v[j].x + v[j].y * v[j].y) + (v[j].z * v[j].z + v[j].w * v[j].w); }
        const float r = rsqrtf(wave_sum(ss) * (1.f / D) + EPS); float ss2 = 0.f;
#pragma unroll
        for (int j = 0; j < 8; ++j) { const f32x4 g = ((const f32x4*)g1)[lane + 64 * j]; f32x4 xv = xr[64 * j];
            xv.x += v[j].x * r * g.x; xv.y += v[j].y * r * g.y; xv.z += v[j].z * r * g.z; xv.w += v[j].w * r * g.w;
            xr[64 * j] = xv; v[j] = xv; ss2 += (xv.x * xv.x + xv.y * xv.y) + (xv.z * xv.z + xv.w * xv.w); }
        if (g2 != nullptr) {
            const float r2 = rsqrtf(wave_sum(ss2) * (1.f / D) + EPS);
            unsigned long long* o8 = (unsigned long long*)(hb + (size_t)row * D) + lane;
#pragma unroll
            for (int j = 0; j < 8; ++j) { const f32x4 g = ((const f32x4*)g2)[lane + 64 * j];
                o8[64 * j] = (unsigned long long)pk2(v[j].x * r2 * g.x, v[j].y * r2 * g.y) | ((unsigned long long)pk2(v[j].z * r2 * g.z, v[j].w * r2 * g.w) << 32); }
        }
    }
}
__device__ __forceinline__ void ph_prep_attn(int gw, int NGW, int lane, const bf16* Z, const float* qn, const float* kn, const float* RC, const float* RS, bf16* QB, bf16* KB, bf16* VB) {
    asm volatile("" : "+v"(lane), "+s"(gw));
    const float qw = qn[lane], kw = kn[lane];
    for (int it = gw; it < S * 24; it += NGW) {
        const int t = it / 24, slot = it % 24;
        if (slot >= 20) { const int h = slot - 20; VB[(size_t)t * ATKV + h * 64 + lane] = Z[(size_t)t * ZP + COL_AV + h * 64 + lane]; continue; }
        const bool isq = slot < 16; const int h = isq ? slot : slot - 16;
        const float c = RC[t * 64 + lane], s = RS[t * 64 + lane];
        const float x = bf2f(Z[(size_t)t * ZP + (isq ? COL_AQ : COL_AK) + h * 64 + lane]);
        const float ss = wave_sum(x * x);
        const float xn = x * rsqrtf(ss * (1.f / 64.f) + EPS) * (isq ? qw : kw);
        const float p = shfl_xor_l(xn, lane, 16);
        const float o = (lane & 16) ? (xn * c + p * s) : (xn * c - p * s);
        if (isq) QB[(size_t)t * ATQ + h * 64 + lane] = (bf16)f2bf(o * QSCALE);
        else KB[(size_t)t * ATKV + h * 64 + lane] = (bf16)f2bf(o);
    }
}
__device__ __forceinline__ void ph_post(int gw, int NGW, int lane, const float* YF, const bf16* V, const bf16* G, const float* BONUS, const float* ln_w, const float* ln_b, bf16* YCAT) {
    asm volatile("" : "+v"(lane), "+s"(gw));
    for (int it = gw; it < S * 16; it += NGW) {
        const int t = it >> 4, h = it & 15, c = h * 64 + lane; const size_t o = (size_t)t * 1024 + c;
        const float y = YF[o] + YF[(size_t)S * 1024 + o];
        const float mu = wave_sum(y) * (1.f / 64.f); const float dlt = y - mu;
        const float var = wave_sum(dlt * dlt) * (1.f / 64.f);
        float yn = dlt * rsqrtf(var + GN_EPS) * ln_w[c] + ln_b[c];
        yn += BONUS[t * 16 + h] * bf2f(V[o]); yn *= bf2f(G[o]);
        YCAT[(size_t)t * 2048 + c] = (bf16)f2bf(yn);
    }
}
typedef float xf32x4 __attribute__((ext_vector_type(4)));
__device__ __forceinline__ bf16x8 ld_perm_g(const bf16* p) { const uint2 lo = *(const uint2*)p, hi = *(const uint2*)(p + 16); const v4u v = {lo.x, lo.y, hi.x, hi.y}; return __builtin_bit_cast(bf16x8, v); }
__device__ __forceinline__ unsigned cvtpk_x(float lo, float hi) { unsigned r; asm volatile("v_cvt_pk_bf16_f32 %0, %1, %2" : "=v"(r) : "v"(lo), "v"(hi)); return r; }
__device__ __forceinline__ void ph_xattn(int gw, int NGW, int lane, const bf16* XQ, const bf16* MK, int kp, const bf16* VT, int vp, bf16* XO) {
    asm volatile("" : "+v"(lane), "+s"(gw));
    const int l15 = lane & 15, q = lane >> 4;
    for (int it = gw; it < (S / 16) * 4; it += NGW) {
        const int t0 = (it >> 2) * 16, h = it & 3;
        bf16x8 qf[4];
#pragma unroll
        for (int ks = 0; ks < 4; ++ks) qf[ks] = *(const bf16x8*)(XQ + (size_t)(t0 + l15) * XW + h * 128 + 8 * q + 32 * ks);
        xf32x4 s[16];
        const bf16* kptr = MK + (size_t)l15 * kp + h * 128 + 8 * q;
#pragma unroll
        for (int kb = 0; kb < 16; ++kb) { s[kb] = (xf32x4){0.f, 0.f, 0.f, 0.f};
            asm volatile("" : "+v"(kptr));
#pragma unroll
            for (int ks = 0; ks < 4; ++ks) s[kb] = __builtin_amdgcn_mfma_f32_16x16x32_bf16(*(const bf16x8*)(kptr + 32 * ks), qf[ks], s[kb], 0, 0, 0);
            kptr += (size_t)16 * kp;
            if (kb & 1) asm volatile("" ::: "memory"); }
        float mx = -1e30f;
#pragma unroll
        for (int kb = 0; kb < 16; ++kb) mx = fmaxf(fmaxf(fmaxf(mx, s[kb][0]), fmaxf(s[kb][1], s[kb][2])), s[kb][3]);
        mx = fmaxf(mx, shfl_xor_l(mx, lane, 16)); mx = fmaxf(mx, shfl_xor_l(mx, lane, 32));
        float sum = 0.f;
#pragma unroll
        for (int kb = 0; kb < 16; ++kb)
#pragma unroll
            for (int r = 0; r < 4; ++r) { const float pv = exp2f(s[kb][r] - mx); s[kb][r] = pv; sum += pv; }
        sum += shfl_xor_l(sum, lane, 16); sum += shfl_xor_l(sum, lane, 32);
        bf16x8 pf[8];
#pragma unroll
        for (int ks = 0; ks < 8; ++ks) { const v4u v = {cvtpk_x(s[2 * ks][0], s[2 * ks][1]), cvtpk_x(s[2 * ks][2], s[2 * ks][3]), cvtpk_x(s[2 * ks + 1][0], s[2 * ks + 1][1]), cvtpk_x(s[2 * ks + 1][2], s[2 * ks + 1][3])}; pf[ks] = __builtin_bit_cast(bf16x8, v); }
        float inv[4];
#pragma unroll
        for (int r = 0; r < 4; ++r) inv[r] = 1.0f / __builtin_bit_cast(float, __builtin_amdgcn_ds_bpermute((4 * q + r) << 2, __builtin_bit_cast(int, sum)));
        const bf16* vptr = VT + (size_t)(h * 128 + l15) * vp + 4 * q; bf16* optr = XO + (size_t)(t0 + 4 * q) * XW + h * 128 + l15;
#pragma unroll
        for (int db = 0; db < 8; ++db) { xf32x4 o = (xf32x4){0.f, 0.f, 0.f, 0.f};
            asm volatile("" : "+v"(vptr));
#pragma unroll
            for (int ks = 0; ks < 8; ++ks) o = __builtin_amdgcn_mfma_f32_16x16x32_bf16(pf[ks], ld_perm_g(vptr + 32 * ks), o, 0, 0, 0);
            vptr += (size_t)16 * vp;
#pragma unroll
            for (int r = 0; r < 4; ++r) optr[r * XW + 16 * db] = (bf16)f2bf(o[r] * inv[r]);
            asm volatile("" ::: "memory"); }
    }
}
struct PrepArgs {
    const bf16* Z; const float *mu_p, *mu_n, *w0, *w_up, *a0, *a_up, *g_up, *v0, *v_down, *v_up, *k_k, *k_a, *r_k; const bf16* VFIRST;
    bf16 *R, *V, *KK, *KD0, *KD1, *B0, *B1, *G; float *LW0, *LW1, *BONUS; int layer;
};
__device__ __forceinline__ float zshift(const bf16* Z, const float* mu_p, const float* mu_n, int t, int col) {
    const float z = bf2f(Z[(size_t)t * ZP + col]);
    const float zp = t > 0 ? bf2f(Z[(size_t)(t - 1) * ZP + col]) : 0.f;
    const float zn = t < S - 1 ? bf2f(Z[(size_t)(t + 1) * ZP + col]) : 0.f;
    return z + mu_p[col] * (zp - z) + mu_n[col] * (zn - z);
}
constexpr int PT = 8;
__device__ __forceinline__ void ph_prep_rwkv(LAS unsigned char* lds, const PrepArgs& p, int vcu, int G, int wv) {
    int lane_l = lane_id(); asm volatile("" : "+v"(lane_l), "+s"(wv), "+s"(vcu));
    const int lane = lane_l, tid = __builtin_amdgcn_readfirstlane(wv) * 64 + lane;
    LAS float* sm = (LAS float*)lds;
    LAS float* vs = sm + PT * 416;
    LAS float* vdl = vs + PT * 1024;
    for (int tile = vcu; tile < S / PT; tile += G) {
        const int t0 = tile * PT;
        for (int idx = tid; idx < PT * 416; idx += 512) { const int tok = idx / 416, c = idx % 416;
            float z = zshift(p.Z, p.mu_p, p.mu_n, t0 + tok, COL_WD + c);
            if (c < 128) z = tanhf(z); else if (c >= 256) z = sigmoidf_(z);
            sm[tok * 416 + c] = z; }
        for (int idx = tid; idx < PT * 1024; idx += 512) { const int tok = idx >> 10, c = idx & 1023; vs[tok * 1024 + c] = zshift(p.Z, p.mu_p, p.mu_n, t0 + tok, COL_V + c); }
        __syncthreads();
        if (p.layer > 0 && tid < 256) { const int tok = tid >> 5, o = tid & 31; float acc = 0.f;
            for (int c = 0; c < 1024; ++c) acc += vs[tok * 1024 + c] * p.v_down[c * 32 + o];
            vdl[tok * 32 + o] = acc; }
        __syncthreads();
        for (int i = 0; i < 2; ++i) {
            const int c = tid + 512 * i, head = c >> 6;
            float aw0[PT], aw1[PT], aa0[PT], aa1[PT], ag[PT], avm[PT];
            { const float b0 = p.w0[c], b1 = p.w0[1024 + c], c0 = p.a0[c], c1 = p.a0[1024 + c], d0 = p.layer > 0 ? p.v0[c] : 0.f;
#pragma unroll
              for (int k = 0; k < PT; ++k) { aw0[k] = b0; aw1[k] = b1; aa0[k] = c0; aa1[k] = c1; ag[k] = 0.f; avm[k] = d0; } }
            for (int m = 0; m < 64; ++m) {
                const float u0 = p.w_up[(size_t)m * 1024 + c], u1 = p.w_up[(size_t)(64 + m) * 1024 + c], q0 = p.a_up[(size_t)m * 1024 + c], q1 = p.a_up[(size_t)(64 + m) * 1024 + c];
#pragma unroll
                for (int k = 0; k < PT; ++k) { aw0[k] += sm[k * 416 + m] * u0; aw1[k] += sm[k * 416 + 64 + m] * u1; aa0[k] += sm[k * 416 + 128 + m] * q0; aa1[k] += sm[k * 416 + 192 + m] * q1; }
            }
            for (int m = 0; m < 160; ++m) { const float gu = p.g_up[(size_t)m * 1024 + c];
#pragma unroll
                for (int k = 0; k < PT; ++k) ag[k] += sm[k * 416 + 256 + m] * gu; }
            if (p.layer > 0)
                for (int o = 0; o < 32; ++o) { const float vu = p.v_up[(size_t)o * 1024 + c];
#pragma unroll
                    for (int k = 0; k < PT; ++k) avm[k] += vdl[k * 32 + o] * vu; }
            const float kkw = p.k_k[c], kaw = p.k_a[c], rkw = p.r_k[c];
#pragma unroll
            for (int k = 0; k < PT; ++k) {
                const int t = t0 + k; const size_t o = (size_t)t * 1024 + c;
                const float r = zshift(p.Z, p.mu_p, p.mu_n, t, COL_R + c), kx = zshift(p.Z, p.mu_p, p.mu_n, t, COL_K + c);
                float v = vs[k * 1024 + c];
                if (p.layer > 0) { const float gate = sigmoidf_(avm[k]); const float vf = bf2f(p.VFIRST[o]); v = v + (vf - v) * gate; }
                const float lw0 = -0.6065306597126334f * sigmoidf_(aw0[k]), lw1 = -0.6065306597126334f * sigmoidf_(aw1[k]);
                const float a_0 = sigmoidf_(aa0[k]), a_1 = sigmoidf_(aa1[k]);
                const float kkr = kx * kkw; const float n2 = wave_sum(kkr * kkr);
                const float kk = kkr / fmaxf(sqrtf(n2), 1e-12f);
                const float kd0 = kx * (1.f + (a_0 - 1.f) * kaw), kd1 = kx * (1.f + (a_1 - 1.f) * kaw);
                const float bon = wave_sum(r * (kd0 + kd1) * rkw);
                p.R[o] = (bf16)f2bf(r); p.V[o] = (bf16)f2bf(v); p.KK[o] = (bf16)f2bf(kk); p.KD0[o] = (bf16)f2bf(kd0); p.KD1[o] = (bf16)f2bf(kd1);
                p.B0[o] = (bf16)f2bf(kk * a_0); p.B1[o] = (bf16)f2bf(kk * a_1); p.G[o] = (bf16)f2bf(ag[k]); p.LW0[o] = lw0; p.LW1[o] = lw1;
                if (lane == 0) p.BONUS[t * 16 + head] = bon;
            }
        }
        __syncthreads();
    }
}


namespace pg8 {
#define PG8_LAS __attribute__((address_space(3)))
typedef unsigned short bf16_t;
typedef short bf16x8 __attribute__((ext_vector_type(8)));
typedef float f32x4 __attribute__((ext_vector_type(4)));
typedef unsigned u32x4 __attribute__((ext_vector_type(4)));
constexpr int BM = 256, BK = 64, HALF = 128, HTB = HALF * BK * 2  , STAGE_BYTES = 8 * HTB, NXCD = 8, WGM = 8;

__host__ __device__ __forceinline__ int lds_byte(int r, int c) { const int st = (r >> 4) * 2 + (c >> 5), rr = r & 15, cc = c & 31, ob = rr * 64 + cc * 2; return st * 1024 + (ob ^ (((ob >> 9) & 1) << 5)); }
__host__ __device__ __forceinline__ void stage_rc(int b, int& R, int& C) { const int st = b / 1024, sb = b % 1024, swz = sb ^ (((sb >> 9) & 1) << 5); R = (st >> 1) * 16 + swz / 64; C = (st & 1) * 32 + (swz % 64) / 2; }
__host__ __device__ __forceinline__ int perm32(int rho) { const int n = rho >> 4, i = rho & 15; return 8 * (i >> 2) + 4 * n + (i & 3); }

struct Unit { int pm, pn; };
struct Gemm { const bf16_t* A; const bf16_t* Bt; int M, N, K; };

struct StaticOrder {
    int nM, nN, nwg, G, c;
    __host__ __device__ void init(int M, int N, int G_, int c_) { nM = M / BM; nN = N / BM; nwg = nM * nN; G = G_; c = c_; }
    __host__ __device__ bool next(int i, Unit& u) const {
        const long L = (long)i * G + c; if (L >= nwg) return false;
        int wgid = (int)L; { const int q = nwg / NXCD, r = nwg % NXCD, xcd = wgid % NXCD, off = wgid / NXCD; wgid = (xcd < r ? xcd * (q + 1) : r * (q + 1) + (xcd - r) * q) + off; }
        const int nig = WGM * nN, gid = wgid / nig, fm = gid * WGM, gsz = (nM - fm) < WGM ? (nM - fm) : WGM;
        u.pm = fm + ((wgid % nig) % gsz); u.pn = (wgid % nig) / gsz; return true;
    }
    __device__ __forceinline__ void a_ready(const Unit&) const {}
    __device__ __forceinline__ void done(const Unit&) const {}
};


__device__ __forceinline__ unsigned cvt_pk_bf16(float lo, float hi) { unsigned r; asm volatile("v_cvt_pk_bf16_f32 %0, %1, %2" : "=v"(r) : "v"(lo), "v"(hi)); return r; }

typedef float f32x2 __attribute__((ext_vector_type(2)));
struct EpiBf16S {
    static constexpr bool PERM = true, AFTER_DRAIN = false, MID = false;
    bf16_t* O; int ldc; float scale;
    __device__ __forceinline__ void operator()(const f32x4 (&acc)[2][2][4][2], const Unit& u, int wr, int wc, int fr, int fq) const {
        int row0 = u.pm * BM + wr * 64 + fr; asm volatile("" : "+v"(row0)); const int col0 = u.pn * BM + wc * 32 + 8 * fq;
#pragma unroll
        for (int ai = 0; ai < 2; ++ai)
#pragma unroll
            for (int m = 0; m < 4; ++m) { bf16_t* rowp = O + (size_t)(row0 + ai * HALF + m * 16) * ldc + col0;
#pragma unroll
                for (int bj = 0; bj < 2; ++bj) { const f32x4 v0 = acc[ai][bj][m][0] * scale, v1 = acc[ai][bj][m][1] * scale;
                    u32x4 w; w.x = cvt_pk_bf16(v0[0], v0[1]); w.y = cvt_pk_bf16(v0[2], v0[3]); w.z = cvt_pk_bf16(v1[0], v1[1]); w.w = cvt_pk_bf16(v1[2], v1[3]);
                    *(u32x4*)(rowp + bj * HALF) = w; } }
    }
};
struct EpiF32 {
    static constexpr bool PERM = false, AFTER_DRAIN = false, MID = false;
    float* O; int ldc;
    __device__ __forceinline__ void operator()(const f32x4 (&acc)[2][2][4][2], const Unit& u, int wr, int wc, int fr, int fq) const {
        int row0 = u.pm * BM + wr * 64 + fr; asm volatile("" : "+v"(row0)); const int col0 = u.pn * BM + wc * 32 + 4 * fq;
#pragma unroll
        for (int ai = 0; ai < 2; ++ai)
#pragma unroll
            for (int m = 0; m < 4; ++m) { float* rowp = O + (size_t)(row0 + ai * HALF + m * 16) * ldc + col0;
#pragma unroll
                for (int bj = 0; bj < 2; ++bj)
#pragma unroll
                    for (int n = 0; n < 2; ++n) *(f32x4*)(rowp + bj * HALF + n * 16) = acc[ai][bj][m][n]; }
    }
};
__device__ __forceinline__ float silu_mul(float g, float u) { return g * u * __builtin_amdgcn_rcpf(1.0f + __expf(-g)); }
struct EpiSwiGLU {
    static constexpr bool PERM = true, AFTER_DRAIN = false, MID = false;
    bf16_t* O; int ldc;
    __device__ __forceinline__ void operator()(const f32x4 (&acc)[2][2][4][2], const Unit& u, int wr, int wc, int fr, int fq) const {
        int row0 = u.pm * BM + wr * 64 + fr; asm volatile("" : "+v"(row0)); const int col0 = u.pn * HALF + wc * 32 + 8 * fq;
#pragma unroll
        for (int ai = 0; ai < 2; ++ai)
#pragma unroll
            for (int m = 0; m < 4; ++m) { bf16_t* rowp = O + (size_t)(row0 + ai * HALF + m * 16) * ldc + col0;
                const f32x4 g0 = acc[ai][0][m][0], g1 = acc[ai][0][m][1], u0 = acc[ai][1][m][0], u1 = acc[ai][1][m][1];
                u32x4 w; w.x = cvt_pk_bf16(silu_mul(g0[0], u0[0]), silu_mul(g0[1], u0[1])); w.y = cvt_pk_bf16(silu_mul(g0[2], u0[2]), silu_mul(g0[3], u0[3]));
                w.z = cvt_pk_bf16(silu_mul(g1[0], u1[0]), silu_mul(g1[1], u1[1])); w.w = cvt_pk_bf16(silu_mul(g1[2], u1[2]), silu_mul(g1[3], u1[3]));
                *(u32x4*)rowp = w; }
    }
};
struct EpiMerge {
    static constexpr bool PERM = true, AFTER_DRAIN = false, MID = true;
    const bf16_t* Z; bf16_t* O;
    __device__ __forceinline__ static void unpack8(const u32x4 r, float (&f)[8]) {
        f[0] = __builtin_bit_cast(float, r.x << 16); f[1] = __builtin_bit_cast(float, r.x & 0xffff0000u); f[2] = __builtin_bit_cast(float, r.y << 16); f[3] = __builtin_bit_cast(float, r.y & 0xffff0000u);
        f[4] = __builtin_bit_cast(float, r.z << 16); f[5] = __builtin_bit_cast(float, r.z & 0xffff0000u); f[6] = __builtin_bit_cast(float, r.w << 16); f[7] = __builtin_bit_cast(float, r.w & 0xffff0000u);
    }
    __device__ __forceinline__ void mid(f32x4 (&acc)[2][2][4][2], const Unit& u, int wr, int wc, int fr, int fq) const {
        int row0 = u.pm * BM + wr * 64 + fr; asm volatile("" : "+v"(row0)); const int col0 = u.pn * BM + wc * 32 + 8 * fq;
#pragma unroll
        for (int ai = 0; ai < 2; ++ai)
#pragma unroll
            for (int m = 0; m < 4; ++m) { const bf16_t* zr = Z + (size_t)(row0 + ai * HALF + m * 16) * ZP + col0;
#pragma unroll
                for (int bj = 0; bj < 2; ++bj) { float a[8], b[8]; unpack8(*(const u32x4*)(zr + COL_G1 + bj * HALF), a); unpack8(*(const u32x4*)(zr + COL_G2 + bj * HALF), b);
#pragma unroll
                    for (int e = 0; e < 8; ++e) { const float r = (1.0f + __expf(-fmaxf(b[e], -60.f))) * __builtin_amdgcn_rcpf(1.0f + __expf(-a[e])); acc[ai][bj][m][e >> 2][e & 3] *= r; } }
                if (m & 1) asm volatile("" ::: "memory"); }
    }
    __device__ __forceinline__ void operator()(const f32x4 (&acc)[2][2][4][2], const Unit& u, int wr, int wc, int fr, int fq) const {
        int row0 = u.pm * BM + wr * 64 + fr; asm volatile("" : "+v"(row0)); const int col0 = u.pn * BM + wc * 32 + 8 * fq;
#pragma unroll
        for (int ai = 0; ai < 2; ++ai)
#pragma unroll
            for (int m = 0; m < 4; ++m) { const bf16_t* zr = Z + (size_t)(row0 + ai * HALF + m * 16) * ZP + col0; bf16_t* rowp = O + (size_t)(row0 + ai * HALF + m * 16) * 2048 + col0;
#pragma unroll
                for (int bj = 0; bj < 2; ++bj) { float b[8], o[8]; unpack8(*(const u32x4*)(zr + COL_G2 + bj * HALF), b);
#pragma unroll
                    for (int e = 0; e < 8; ++e) o[e] = acc[ai][bj][m][e >> 2][e & 3] * __builtin_amdgcn_rcpf(1.0f + __expf(-fmaxf(b[e], -60.f)));
                    u32x4 w; w.x = cvt_pk_bf16(o[0], o[1]); w.y = cvt_pk_bf16(o[2], o[3]); w.z = cvt_pk_bf16(o[4], o[5]); w.w = cvt_pk_bf16(o[6], o[7]);
                    *(u32x4*)(rowp + bj * HALF) = w; }
                if (m & 1) asm volatile("" ::: "memory"); }
    }
};
template <class Epi, class Sched, bool ALIGN_EPI = false, bool SP2 = false>
__device__ __forceinline__ void gemm_phase(PG8_LAS unsigned char* lds, const Gemm g, const Sched& S, const Epi& E, int wv) {
    int lane_l = lane_id(); asm volatile("" : "+v"(lane_l));
    asm volatile("" : "+s"(wv));
    const int wid = __builtin_amdgcn_readfirstlane(wv), tid = wid * 64 + lane_l, lane = lane_l, wr = wid >> 2, wc = wid & 3, fr = lane & 15, fq = lane >> 4;
    const int K = g.K, nt = K / BK;
    unsigned voffA[2], voffB[2];
#pragma unroll
    for (int i = 0; i < 2; ++i) { int R, C; stage_rc(tid * 16 + i * 8192, R, C); const int Rb = Epi::PERM ? ((R & ~31) + perm32(R & 31)) : R;
        voffA[i] = (unsigned)(R * K + C) * 2u; voffB[i] = (unsigned)(Rb * K + C) * 2u; }
    const size_t kstep = (size_t)(BK * 2);
    const size_t hstep = (size_t)HALF * K * 2;
    const size_t tstep = 2 * hstep;
    const unsigned ldsw = (unsigned)wid * 1024u;
    const int aoff = lds_byte(wr * 64 + fr, fq * 8), boff = lds_byte(wc * 32 + fr, fq * 8);
#define PG8_SA(b, h) (((b) * 2 + (h)) * HTB)
#define PG8_SB(b, h) ((4 + (b) * 2 + (h)) * HTB)
#define PG8_STAGE(bufoff, gbase, voff) do { _Pragma("unroll") for (int _i = 0; _i < 2; ++_i) \
        __builtin_amdgcn_global_load_lds((const unsigned*)((const char*)(gbase) + (voff)[_i]), (PG8_LAS unsigned*)(lds + (bufoff) + ldsw + _i * 8192), 16, 0, 0); } while (0)
#define PG8_LDA(dst, b, h) do { _Pragma("unroll") for (int m = 0; m < 4; ++m) _Pragma("unroll") for (int k = 0; k < 2; ++k) dst[m][k] = *(const PG8_LAS bf16x8*)(lds + PG8_SA(b, h) + aoff + m * 2048 + k * 1024); } while (0)
#define PG8_LDB(dst, b, h) do { _Pragma("unroll") for (int n = 0; n < 2; ++n) _Pragma("unroll") for (int k = 0; k < 2; ++k) dst[n][k] = *(const PG8_LAS bf16x8*)(lds + PG8_SB(b, h) + boff + n * 2048 + k * 1024); } while (0)
#define PG8_MMA(ai, bj, At, Bt) do { __builtin_amdgcn_s_setprio(1); _Pragma("unroll") for (int m = 0; m < 4; ++m) _Pragma("unroll") for (int n = 0; n < 2; ++n) _Pragma("unroll") for (int k = 0; k < 2; ++k) \
        acc[ai][bj][m][n] = __builtin_amdgcn_mfma_f32_16x16x32_bf16(Bt[n][k], At[m][k], acc[ai][bj][m][n], 0, 0, 0); __builtin_amdgcn_s_setprio(0); } while (0)
#define PG8_WAIT_V(n) asm volatile("s_waitcnt vmcnt(" #n ")" ::: "memory")
#define PG8_WAIT_L(n) asm volatile("s_waitcnt lgkmcnt(" #n ")" ::: "memory")
#define PG8_BAR __builtin_amdgcn_s_barrier()
#define PG8_SCHED __builtin_amdgcn_sched_barrier(0)
    Unit cur, nxt; int ui = 0;
    if (!S.next(0, cur)) return;
    f32x4 acc[2][2][4][2];
#pragma unroll
    for (int a = 0; a < 2; ++a)
#pragma unroll
        for (int b = 0; b < 2; ++b)
#pragma unroll
            for (int m = 0; m < 4; ++m)
#pragma unroll
                for (int n = 0; n < 2; ++n) acc[a][b][m][n] = (f32x4){0.f, 0.f, 0.f, 0.f};
    bf16x8 At[4][2], B0[2][2], B1[2][2];
    const char* cA = (const char*)g.A + (size_t)cur.pm * tstep; const char* cB = (const char*)g.Bt + (size_t)cur.pn * tstep;
    S.a_ready(cur);
    if constexpr (SP2) {
        PG8_STAGE(PG8_SB(0, 0), cB, voffB); PG8_STAGE(PG8_SB(0, 1), cB + hstep, voffB); PG8_STAGE(PG8_SA(0, 0), cA, voffA); PG8_STAGE(PG8_SA(0, 1), cA + hstep, voffA);
        if (wr == 1) PG8_BAR;
        PG8_WAIT_V(2); PG8_BAR;
        PG8_STAGE(PG8_SB(1, 0), cB + kstep, voffB); PG8_STAGE(PG8_SA(1, 0), cA + kstep, voffA); PG8_STAGE(PG8_SB(1, 1), cB + hstep + kstep, voffB);
        PG8_WAIT_V(6); PG8_BAR;
    } else {
        PG8_STAGE(PG8_SB(0, 0), cB, voffB); PG8_STAGE(PG8_SA(0, 0), cA, voffA); PG8_STAGE(PG8_SB(0, 1), cB + hstep, voffB); PG8_STAGE(PG8_SA(0, 1), cA + hstep, voffA);
        if (wr == 1) PG8_BAR;
        PG8_WAIT_V(4); PG8_BAR;
        PG8_STAGE(PG8_SB(1, 0), cB + kstep, voffB); PG8_STAGE(PG8_SA(1, 0), cA + kstep, voffA); PG8_STAGE(PG8_SB(1, 1), cB + hstep + kstep, voffB);
        PG8_WAIT_V(6); PG8_BAR;
    }
    for (;;) {
        const bool has_next = S.next(ui + 1, nxt);
        const char* nA = has_next ? (const char*)g.A + (size_t)nxt.pm * tstep : cA; const char* nB = has_next ? (const char*)g.Bt + (size_t)nxt.pn * tstep : cB;
        for (int t = 0; t < nt; t += 2) {
            const bool last = (t == nt - 2);
            if constexpr (Epi::MID) { if (t == (nt >> 1)) E.mid(acc, cur, wr, wc, fr, fq); }
            const char* a1 = cA + (size_t)(t + 1) * kstep;
            const char* a2 = last ? nA : cA + (size_t)(t + 2) * kstep; const char* b2 = last ? nB : cB + (size_t)(t + 2) * kstep;
            const char* a3 = a2 + kstep; const char* b3 = b2 + kstep;
            if (last && has_next) S.a_ready(nxt);
            if constexpr (SP2) {
            PG8_LDB(B0, 0, 0); PG8_LDB(B1, 0, 1); PG8_SCHED; PG8_LDA(At, 0, 0); PG8_STAGE(PG8_SA(1, 1), a1 + hstep, voffA);
            PG8_WAIT_V(8); PG8_WAIT_L(0); PG8_BAR; PG8_MMA(0, 0, At, B0); PG8_MMA(0, 1, At, B1); PG8_BAR; PG8_SCHED;
            PG8_LDA(At, 0, 1); PG8_STAGE(PG8_SB(0, 0), b2, voffB); PG8_STAGE(PG8_SB(0, 1), b2 + hstep, voffB); PG8_STAGE(PG8_SA(0, 0), a2, voffA);
            PG8_WAIT_V(8); PG8_WAIT_L(0); PG8_BAR; PG8_MMA(1, 0, At, B0); PG8_MMA(1, 1, At, B1); PG8_BAR; PG8_SCHED;
            PG8_LDB(B0, 1, 0); PG8_LDB(B1, 1, 1); PG8_SCHED; PG8_LDA(At, 1, 0); PG8_STAGE(PG8_SA(0, 1), a2 + hstep, voffA);
            PG8_WAIT_V(8); PG8_WAIT_L(0); PG8_BAR; PG8_MMA(0, 0, At, B0); PG8_MMA(0, 1, At, B1); PG8_BAR; PG8_SCHED;
            PG8_LDA(At, 1, 1); PG8_STAGE(PG8_SB(1, 0), b3, voffB); PG8_STAGE(PG8_SB(1, 1), b3 + hstep, voffB); PG8_STAGE(PG8_SA(1, 0), a3, voffA);
            PG8_WAIT_V(8); PG8_WAIT_L(0); PG8_BAR; PG8_MMA(1, 0, At, B0); PG8_MMA(1, 1, At, B1); PG8_BAR; PG8_SCHED;
            } else {
            PG8_LDB(B0, 0, 0); PG8_SCHED; PG8_LDA(At, 0, 0); PG8_STAGE(PG8_SA(1, 1), a1 + hstep, voffA);
            PG8_WAIT_L(8); PG8_BAR; PG8_WAIT_L(0); PG8_MMA(0, 0, At, B0); PG8_BAR; PG8_SCHED;
            PG8_LDB(B1, 0, 1); PG8_STAGE(PG8_SB(0, 0), b2, voffB);
            PG8_BAR; PG8_WAIT_L(0); PG8_MMA(0, 1, At, B1); PG8_BAR;
            PG8_LDA(At, 0, 1); PG8_STAGE(PG8_SA(0, 0), a2, voffA);
            PG8_BAR; PG8_WAIT_L(0); PG8_MMA(1, 0, At, B0); PG8_BAR; PG8_SCHED;
            PG8_STAGE(PG8_SB(0, 1), b2 + hstep, voffB);
            PG8_WAIT_V(6); PG8_BAR; PG8_MMA(1, 1, At, B1); PG8_BAR;
            PG8_LDB(B0, 1, 0); PG8_SCHED; PG8_LDA(At, 1, 0); PG8_STAGE(PG8_SA(0, 1), a2 + hstep, voffA);
            PG8_WAIT_L(8); PG8_BAR; PG8_WAIT_L(0); PG8_MMA(0, 0, At, B0); PG8_BAR; PG8_SCHED;
            PG8_LDB(B1, 1, 1); PG8_STAGE(PG8_SB(1, 0), b3, voffB);
            PG8_BAR; PG8_WAIT_L(0); PG8_MMA(0, 1, At, B1); PG8_BAR;
            PG8_LDA(At, 1, 1); PG8_STAGE(PG8_SA(1, 0), a3, voffA);
            PG8_BAR; PG8_WAIT_L(0); PG8_MMA(1, 0, At, B0); PG8_BAR; PG8_SCHED;
            PG8_STAGE(PG8_SB(1, 1), b3 + hstep, voffB);
            PG8_WAIT_V(6); PG8_BAR; PG8_MMA(1, 1, At, B1); PG8_BAR;
            }
        }
        if constexpr (ALIGN_EPI) { if (wr == 0) PG8_BAR; }
        if constexpr (!Epi::AFTER_DRAIN) { E(acc, cur, wr, wc, fr, fq); S.done(cur); }
        if (!has_next) break;
#pragma unroll
        for (int a = 0; a < 2; ++a)
#pragma unroll
            for (int b = 0; b < 2; ++b)
#pragma unroll
                for (int m = 0; m < 4; ++m)
#pragma unroll
                    for (int n = 0; n < 2; ++n) acc[a][b][m][n] = (f32x4){0.f, 0.f, 0.f, 0.f};
        cur = nxt; cA = nA; cB = nB; ++ui;
        if constexpr (ALIGN_EPI) { if (wr == 1) PG8_BAR; }
    }
    PG8_WAIT_V(0);
    if constexpr (!ALIGN_EPI) { if (wr == 0) PG8_BAR; }
    PG8_BAR;
    if constexpr (Epi::AFTER_DRAIN) { E.fused(acc, cur, wr, wc, fr, fq, lds, wid, lane); S.done(cur); }
#undef PG8_SA
#undef PG8_SB
#undef PG8_STAGE
#undef PG8_LDA
#undef PG8_LDB
#undef PG8_MMA
#undef PG8_WAIT_V
#undef PG8_WAIT_L
#undef PG8_BAR
#undef PG8_SCHED
}
}


#include <hip/hip_bf16.h>
#include <cmath>
namespace attn_body {
using bf16=__hip_bfloat16;
using bf16x8=__attribute__((ext_vector_type(8)))short;
using s16x4=__attribute__((ext_vector_type(4)))short;
using f32x16=__attribute__((ext_vector_type(16)))float;
using u32x4=__attribute__((ext_vector_type(4)))unsigned;
constexpr int NHEAD=16,SEQ=8192,D=64,QP=1024,KVP=256,OP=2048;
constexpr int NW=8,QBLK=32,QB=QBLK*NW,KVBLK=64,NQB=SEQ/QB;
constexpr int ATTN_UNIT_ROWS=QB;
__device__ __forceinline__ int crow(int r,int hi){return (r&3)+8*(r>>2)+4*hi;}
#define SBAR() __builtin_amdgcn_sched_barrier(0)
__device__ __forceinline__ void cmask(f32x16&p0,f32x16&p1,int jb,int qrel,int hi){
  const float NEG=-INFINITY; int kb=64*jb+4*hi;
  #pragma unroll
  for(int r=0;r<16;++r){int kv=kb+(r&3)+8*(r>>2); if(kv>qrel)p0[r]=NEG; if(kv+32>qrel)p1[r]=NEG;}
}

constexpr int NSLOT=3, SLOTB=8192;
constexpr int LDS_K=0, LDS_V=NSLOT*SLOTB, LDS_WS=2*NSLOT*SLOTB, LDS_OST=LDS_WS+NW*64*4, LDS_BYTES=LDS_OST+NW*4096;
constexpr float C2=0.125f*1.4426950408889634f;
__device__ __forceinline__ void glds16(const void*gsrc,unsigned lds_dst){unsigned keep;
  asm volatile("s_mov_b32 %0, m0\n\ts_mov_b32 m0, %2\n\ts_nop 0\n\tglobal_load_lds_dwordx4 %1, off\n\ts_mov_b32 m0, %0":"=&s"(keep):"v"(gsrc),"s"(lds_dst):"memory");}
__device__ __forceinline__ float max3f(float a,float b,float c){float r;asm("v_max3_f32 %0, %1, %2, %3":"=v"(r):"v"(a),"v"(b),"v"(c));return r;}
__device__ __forceinline__ float max2f(float a,float b){float r;asm("v_max_f32_e32 %0, %1, %2":"=v"(r):"v"(a),"v"(b));return r;}
__device__ __forceinline__ float fadd_s(float a,float b){float r;asm("v_add_f32_e32 %0, %1, %2":"=v"(r):"v"(a),"v"(b));return r;}
__device__ __forceinline__ float fsub_s(float a,float b){float r;asm("v_sub_f32_e32 %0, %1, %2":"=v"(r):"v"(a),"v"(b));return r;}
typedef float f32x2_t __attribute__((ext_vector_type(2))); typedef __bf16 bf16x2_t __attribute__((ext_vector_type(2)));
__device__ __forceinline__ unsigned cvtpk_s(float lo,float hi){f32x2_t v={lo,hi};bf16x2_t b=__builtin_convertvector(v,bf16x2_t);return __builtin_bit_cast(unsigned,b);}
#define WAIT_BAR(N) asm volatile("s_waitcnt vmcnt(" #N ") lgkmcnt(0)\n\ts_barrier":::"memory")

__device__ __forceinline__ void qkt(f32x16&p0,f32x16&p1,const char*Kslot,const bf16x8*qr,const f32x16&negm,int r32,int hi){
  const char*kb=Kslot+hi*1024+r32*16;
  #pragma unroll
  for(int d0=0;d0<4;++d0){
    const bf16x8 b0=*reinterpret_cast<const bf16x8*>(kb+d0*2048);
    const bf16x8 b1=*reinterpret_cast<const bf16x8*>(kb+d0*2048+512);
    if(d0==0){p0=__builtin_amdgcn_mfma_f32_32x32x16_bf16(b0,qr[0],negm,0,0,0);p1=__builtin_amdgcn_mfma_f32_32x32x16_bf16(b1,qr[0],negm,0,0,0);}
    else{p0=__builtin_amdgcn_mfma_f32_32x32x16_bf16(b0,qr[d0],p0,0,0,0);p1=__builtin_amdgcn_mfma_f32_32x32x16_bf16(b1,qr[d0],p1,0,0,0);}}
}
typedef __attribute__((address_space(3))) const char* lds_cptr;
typedef short v4i16_t __attribute__((ext_vector_type(4)));
__device__ __forceinline__ void kload8(bf16x8*kf,lds_cptr kp){
  kf[0]=*(const __attribute__((address_space(3))) bf16x8*)(kp);      kf[1]=*(const __attribute__((address_space(3))) bf16x8*)(kp+512);
  kf[2]=*(const __attribute__((address_space(3))) bf16x8*)(kp+2048); kf[3]=*(const __attribute__((address_space(3))) bf16x8*)(kp+2560);
  kf[4]=*(const __attribute__((address_space(3))) bf16x8*)(kp+4096); kf[5]=*(const __attribute__((address_space(3))) bf16x8*)(kp+4608);
  kf[6]=*(const __attribute__((address_space(3))) bf16x8*)(kp+6144); kf[7]=*(const __attribute__((address_space(3))) bf16x8*)(kp+6656);
}
__device__ __forceinline__ void kload2(bf16x8*kf,lds_cptr kp,int j){ kf[2*j]=*(const __attribute__((address_space(3))) bf16x8*)(kp+j*2048); kf[2*j+1]=*(const __attribute__((address_space(3))) bf16x8*)(kp+j*2048+512); }
__device__ __forceinline__ s16x4 vtr(lds_cptr p){ return __builtin_bit_cast(s16x4,__builtin_amdgcn_ds_read_tr16_b64_v4i16((__attribute__((address_space(3))) v4i16_t*)p)); }
__device__ __forceinline__ float rowmax(const f32x16&p0,const f32x16&p1){
  float a=max3f(p0[0],p0[1],p1[0]),b=max3f(p0[2],p0[3],p1[1]);a=max3f(a,p1[2],p1[3]);
  #pragma unroll
  for(int r=4;r<16;r+=4){a=max3f(a,p0[r],p0[r+1]);b=max3f(b,p0[r+2],p0[r+3]);a=max3f(a,p1[r],p1[r+1]);b=max3f(b,p1[r+2],p1[r+3]);}
  const float m=max2f(a,b);
  auto rr=__builtin_amdgcn_permlane32_swap(__float_as_uint(m),__float_as_uint(m),false,false);
  return max2f(__uint_as_float(rr[0]),__uint_as_float(rr[1]));
}
__device__ __forceinline__ void pv(f32x16*o,int vb,bf16x8 pa0,bf16x8 pa1,bf16x8 pa2,bf16x8 pa3){
  #pragma unroll
  for(int d0=0;d0<2;++d0){s16x4 lo[4],hi[4];
    #pragma unroll
    for(int ks=0;ks<4;++ks){
      asm volatile("ds_read_b64_tr_b16 %0,%1 offset:%c2":"=&v"(lo[ks]):"v"(vb),"i"(d0*4096+ks*1024):"memory");
      asm volatile("ds_read_b64_tr_b16 %0,%1 offset:%c2":"=&v"(hi[ks]):"v"(vb),"i"(d0*4096+ks*1024+512):"memory");}
    asm volatile("s_waitcnt lgkmcnt(0)":::"memory");SBAR();
    #define PK(k) (bf16x8){lo[k][0],lo[k][1],lo[k][2],lo[k][3],hi[k][0],hi[k][1],hi[k][2],hi[k][3]}
    o[d0]=__builtin_amdgcn_mfma_f32_32x32x16_bf16(pa0,PK(0),o[d0],0,0,0);
    o[d0]=__builtin_amdgcn_mfma_f32_32x32x16_bf16(pa1,PK(1),o[d0],0,0,0);
    o[d0]=__builtin_amdgcn_mfma_f32_32x32x16_bf16(pa2,PK(2),o[d0],0,0,0);
    o[d0]=__builtin_amdgcn_mfma_f32_32x32x16_bf16(pa3,PK(3),o[d0],0,0,0);
    #undef PK
  }
}

#ifndef ATTN_STORE16
#define ATTN_STORE16(p,v) (*(u32x4*)(p)=(v))
#endif
template<int THRL> __device__ __forceinline__ void attn_unit(int wv,int b,int h,int qb,const bf16*Q,const bf16*__restrict__ K,const bf16*__restrict__ V,bf16*O,char*shm){
  int lane_l=lane_id(); asm volatile("":"+v"(lane_l)); asm volatile("":"+s"(wv)); const int lane=lane_l,r32=lane&31,hi=lane>>5; const int wid=__builtin_amdgcn_readfirstlane(wv); const int tid=wid*64+lane; (void)tid;
  const int q0=qb*QB; (void)b;
  const bf16*Qw=Q+(long)(q0+wid*QBLK)*QP+h*D;
  const bf16*Kh=K+(h>>2)*D,*Vh=V+(h>>2)*D;
  const unsigned lds0=(unsigned)(uintptr_t)shm;
  float*wsf=(float*)(shm+LDS_WS)+wid*64;
  const bf16*ksrc=Kh+(long)lane*KVP+wid*8;
  const bf16*vsrc=Vh+(long)(16*(wid&3)+(lane>>2))*KVP+(wid>>2)*32+(lane&3)*8;
  const unsigned kdst=lds0+LDS_K+wid*1024, vdst=lds0+LDS_V+wid*1024;
  #define DMA_K(t,slot) glds16(ksrc+(long)(t)*KVBLK*KVP,(unsigned)__builtin_amdgcn_readfirstlane(kdst+(slot)))
  #define DMA_V(t,slot) glds16(vsrc+(long)(t)*KVBLK*KVP,(unsigned)__builtin_amdgcn_readfirstlane(vdst+(slot)))
  const int vb0=(int)(lds0+LDS_V)+((lane>>4)&1)*32+(lane&3)*8+(4*hi+((lane&15)>>2))*64;
  const char*Kbase=shm+LDS_K; bf16x8 kf[8];
  const lds_cptr shm3=(lds_cptr)shm; const lds_cptr kp0=shm3+LDS_K+hi*1024+r32*16; const lds_cptr vp0=shm3+LDS_V+((lane>>4)&1)*32+(lane&3)*8+(4*hi+((lane&15)>>2))*64;
  const int NT=SEQ/KVBLK;
  DMA_K(0,0);DMA_V(0,0);DMA_K(1,SLOTB);
  bf16x8 qr[4];
  #pragma unroll
  for(int d0=0;d0<4;++d0)qr[d0]=*reinterpret_cast<const bf16x8*>(&Qw[(long)r32*QP+d0*16+hi*8]);
  float mhat=0.f,l_reg=0.f;f32x16 o[2];o[0]=f32x16{};o[1]=f32x16{};f32x16 negm=f32x16{};asm volatile("":"+v"(negm));
  const int qrel=wid*QBLK+r32;
  #define CMASK(P0,P1,t) do{}while(0)
  bool resc=false;
  #define START(P0,P1) do{ const float rm=rowmax(P0,P1); resc=false; \
    { const float dl=rm; mhat=fadd_s(mhat,dl); \
      _Pragma("unroll") for(int r=0;r<16;++r){P0[r]=fsub_s(P0[r],dl);P1[r]=fsub_s(P1[r],dl);} \
      _Pragma("unroll") for(int r=0;r<16;++r)negm[r]=-mhat; asm volatile("":"+v"(negm)); } \
    _Pragma("unroll") for(int r=0;r<16;++r)P0[r]=__builtin_amdgcn_exp2f(P0[r]); }while(0)
  #define RESC() do{ if(resc){ asm volatile("s_waitcnt lgkmcnt(0)":::"memory"); \
      _Pragma("unroll") for(int d_=0;d_<2;++d_) _Pragma("unroll") for(int r=0;r<16;++r)o[d_][r]*=wsf[crow(r,hi)]; } }while(0)
  f32x16 pA0,pA1,pB0,pB1;
  int sl_prev=0,sl_cur=0,sl_next=SLOTB;
  #define ROT() do{sl_prev=sl_cur;sl_cur=sl_next;sl_next=(sl_next==(NSLOT-1)*SLOTB)?0:sl_next+SLOTB;}while(0)
  DMA_K(2,2*SLOTB);
  WAIT_BAR(3);
  qkt(pA0,pA1,Kbase,qr,negm,r32,hi);asm volatile("s_nop 15\n\ts_nop 7":"+v"(pA0),"+v"(pA1));CMASK(pA0,pA1,0);
  START(pA0,pA1);
  _Pragma("unroll") for(int r=0;r<16;++r)pA1[r]=__builtin_amdgcn_exp2f(pA1[r]);
  WAIT_BAR(0);
  DMA_K(3,0);DMA_V(1,SLOTB);
  ROT();
  kload8(kf,kp0+sl_cur);
  WAIT_BAR(2);
  s16x4 vlo[8],vhi[8]; u32x4 pw0,pw1,pw2,pw3;
  #define PKW(P,B) cvtpk_s(P[B],P[B+1])
  #define PAF(k) __builtin_bit_cast(bf16x8,pw##k)
  #define VFR(i) (bf16x8){vlo[i][0],vlo[i][1],vlo[i][2],vlo[i][3],vhi[i][0],vhi[i][1],vhi[i][2],vhi[i][3]}
  #define PIN(x) asm volatile("":"+v"(x))
  #define MX3(a,b,c) __builtin_fmaxf(__builtin_fmaxf((a),(b)),(c))
  #define GAPA(MF,A0,A1,A2,A3,W0,W1,PW) do{ MF; sacc+=A0; sacc+=A1; sacc+=A2; sacc+=A3; PIN(sacc); W0; W1; PIN(PW); SBAR(); }while(0)
  #define EX(v) __builtin_amdgcn_exp2f(v)
  #define GAPB(MF,X,B) do{ MF; X[B]=EX(X[B]); X[B+1]=EX(X[B+1]); X[B+2]=EX(X[B+2]); X[B+3]=EX(X[B+3]); PIN(X); SBAR(); }while(0)
  #define VRD(i) do{ vlo[i]=vtr(vp_+(((i)>>2)*4096+((i)&3)*1024)); vhi[i]=vtr(vp_+(((i)>>2)*4096+((i)&3)*1024+512)); }while(0)
  #define KRD(G,j) do{ if(G){ kload2(kf,kp0+sl_next,j); SBAR(); } }while(0)
  #define STEP(C0,C1,P0,P1,t,GK,GV,GL) do{ SBAR(); \
    const lds_cptr vp_=vp0+sl_prev; \
    VRD(0); SBAR(); float sacc=(P0[0]+P0[1]); \
    GAPA(C0=__builtin_amdgcn_mfma_f32_32x32x16_bf16(kf[0],qr[0],negm,0,0,0), P0[2],P0[3],P0[4],P0[5],     pw0[0]=PKW(P0,0), pw0[1]=PKW(P0,2), pw0); \
    VRD(4); SBAR(); GAPA(C1=__builtin_amdgcn_mfma_f32_32x32x16_bf16(kf[1],qr[0],negm,0,0,0), P0[6],P0[7],P0[8],P0[9],     pw0[2]=PKW(P0,4), pw0[3]=PKW(P0,6), pw0); \
    VRD(1); SBAR(); GAPA(C0=__builtin_amdgcn_mfma_f32_32x32x16_bf16(kf[2],qr[1],C0,0,0,0),   P0[10],P0[11],P0[12],P0[13], pw1[0]=PKW(P0,8), pw1[1]=PKW(P0,10), pw1); \
    VRD(5); SBAR(); GAPA(C1=__builtin_amdgcn_mfma_f32_32x32x16_bf16(kf[3],qr[1],C1,0,0,0),   P0[14],P0[15],P1[0],P1[1],   pw1[2]=PKW(P0,12),pw1[3]=PKW(P0,14), pw1); \
    VRD(2); SBAR(); GAPA(C0=__builtin_amdgcn_mfma_f32_32x32x16_bf16(kf[4],qr[2],C0,0,0,0),   P1[2],P1[3],P1[4],P1[5],     pw2[0]=PKW(P1,0), pw2[1]=PKW(P1,2), pw2); \
    VRD(6); SBAR(); GAPA(C1=__builtin_amdgcn_mfma_f32_32x32x16_bf16(kf[5],qr[2],C1,0,0,0),   P1[6],P1[7],P1[8],P1[9],     pw2[2]=PKW(P1,4), pw2[3]=PKW(P1,6), pw2); \
    VRD(3); SBAR(); GAPA(C0=__builtin_amdgcn_mfma_f32_32x32x16_bf16(kf[6],qr[3],C0,0,0,0),   P1[10],P1[11],P1[12],P1[13], pw3[0]=PKW(P1,8), pw3[1]=PKW(P1,10), pw3); \
    VRD(7); SBAR(); GAPA(C1=__builtin_amdgcn_mfma_f32_32x32x16_bf16(kf[7],qr[3],C1,0,0,0),   P1[14],P1[15],0.f,0.f,       pw3[2]=PKW(P1,12),pw3[3]=PKW(P1,14), pw3); \
    l_reg+=sacc; \
    if(GK){DMA_K((t)+3,sl_cur);} if(GV){DMA_V((t)+1,sl_next);} \
    CMASK(C0,C1,t); \
    { float a=MX3(C0[0],C0[1],C1[0]),b=MX3(C0[2],C0[3],C1[1]); a=MX3(a,C1[2],C1[3]); \
      _Pragma("unroll") for(int r=4;r<16;r+=4){a=MX3(a,C0[r],C0[r+1]);b=MX3(b,C0[r+2],C0[r+3]);a=MX3(a,C1[r],C1[r+1]);b=MX3(b,C1[r+2],C1[r+3]);} \
      float rm=__builtin_fmaxf(a,b); { auto rr=__builtin_amdgcn_permlane32_swap(__float_as_uint(rm),__float_as_uint(rm),false,false); rm=__builtin_fmaxf(__uint_as_float(rr[0]),__uint_as_float(rr[1])); } \
      resc=false; \
      if(__builtin_expect(__any(rm>(float)THRL),0)){ const float dl=__builtin_fmaxf(rm,0.f); mhat+=dl; \
        _Pragma("unroll") for(int r=0;r<16;++r){C0[r]-=dl;C1[r]-=dl;} \
        _Pragma("unroll") for(int r=0;r<16;++r)negm[r]=-mhat; asm volatile("":"+v"(negm)); \
        const float f=__builtin_amdgcn_exp2f(-dl); l_reg*=f; if(hi==0)wsf[r32]=f; resc=true; } } \
    SBAR(); \
    GAPB(o[0]=__builtin_amdgcn_mfma_f32_32x32x16_bf16(PAF(0),VFR(0),o[0],0,0,0), C0,0); \
    GAPB(o[1]=__builtin_amdgcn_mfma_f32_32x32x16_bf16(PAF(0),VFR(4),o[1],0,0,0), C0,4); \
    KRD(GL,0); GAPB(o[0]=__builtin_amdgcn_mfma_f32_32x32x16_bf16(PAF(1),VFR(1),o[0],0,0,0), C0,8); \
    KRD(GL,1); GAPB(o[1]=__builtin_amdgcn_mfma_f32_32x32x16_bf16(PAF(1),VFR(5),o[1],0,0,0), C0,12); \
    KRD(GL,2); GAPB(o[0]=__builtin_amdgcn_mfma_f32_32x32x16_bf16(PAF(2),VFR(2),o[0],0,0,0), C1,0); \
    KRD(GL,3); GAPB(o[1]=__builtin_amdgcn_mfma_f32_32x32x16_bf16(PAF(2),VFR(6),o[1],0,0,0), C1,4); \
    GAPB(o[0]=__builtin_amdgcn_mfma_f32_32x32x16_bf16(PAF(3),VFR(3),o[0],0,0,0), C1,8); \
    GAPB(o[1]=__builtin_amdgcn_mfma_f32_32x32x16_bf16(PAF(3),VFR(7),o[1],0,0,0), C1,12); \
    }while(0)
  int t=1;
  #undef CMASK
  #define CMASK(P0,P1,t) do{}while(0)
  for(;t+5<NT;t+=2){
    STEP(pB0,pB1,pA0,pA1,t,true,true,true);     WAIT_BAR(2); RESC(); ROT();
    STEP(pA0,pA1,pB0,pB1,t+1,true,true,true);   WAIT_BAR(2); RESC(); ROT();
  }
  #undef CMASK
  #define CMASK(P0,P1,t) do{}while(0)
  #define ENDW(tt) do{ if((tt)+3<NT){WAIT_BAR(2);} else if((tt)+2<NT){WAIT_BAR(1);} else {WAIT_BAR(0);} }while(0)
  for(;t+1<NT;t+=2){
    STEP(pB0,pB1,pA0,pA1,t,(t+3<NT),(t+1<NT),(t+1<NT));       ENDW(t);   RESC(); ROT();
    STEP(pA0,pA1,pB0,pB1,t+1,(t+4<NT),(t+2<NT),(t+2<NT));     ENDW(t+1); RESC(); ROT();
  }
  STEP(pB0,pB1,pA0,pA1,NT-1,false,false,false); RESC();
  { float sacc=pB0[0]+pB0[1]; _Pragma("unroll") for(int r=2;r<16;++r)sacc+=pB0[r]; _Pragma("unroll") for(int r=0;r<16;++r)sacc+=pB1[r]; l_reg+=sacc;
    pw0=(u32x4){PKW(pB0,0),PKW(pB0,2),PKW(pB0,4),PKW(pB0,6)};pw1=(u32x4){PKW(pB0,8),PKW(pB0,10),PKW(pB0,12),PKW(pB0,14)};pw2=(u32x4){PKW(pB1,0),PKW(pB1,2),PKW(pB1,4),PKW(pB1,6)};pw3=(u32x4){PKW(pB1,8),PKW(pB1,10),PKW(pB1,12),PKW(pB1,14)};
    SBAR(); pv(o,vb0+sl_cur,PAF(0),PAF(1),PAF(2),PAF(3)); }
  #undef PKW
  #undef PAF
  #undef VFR
  #undef PIN
  #undef MX3
  #undef GAPA
  #undef GAPB
  #undef EX
  #undef VRD
  #undef KRD
  #undef STEP
  #undef ENDW
  {auto rr=__builtin_amdgcn_permlane32_swap(__float_as_uint(l_reg),__float_as_uint(l_reg),false,false);l_reg=__uint_as_float(rr[0])+__uint_as_float(rr[1]);}
  if(hi==0)wsf[32+r32]=l_reg;asm volatile("s_waitcnt lgkmcnt(0)":::"memory");
  float rli[16];
  #pragma unroll
  for(int r=0;r<16;++r)rli[r]=__builtin_amdgcn_rcpf(wsf[32+crow(r,hi)]);
  bf16*Ow=O+(long)(q0+wid*QBLK)*OP+h*D;
  { bf16*stg=(bf16*)(shm+LDS_OST)+wid*2048;
    #pragma unroll
    for(int r=0;r<16;++r){const int orow=crow(r,hi);
      #pragma unroll
      for(int d0=0;d0<2;++d0)stg[orow*64+d0*32+r32]=__float2bfloat16(o[d0][r]*rli[r]);}
    asm volatile("s_waitcnt lgkmcnt(0)":::"memory");
    #pragma unroll
    for(int i=0;i<4;++i){const int row=i*8+(lane>>3),ch=lane&7; const u32x4 v=*(const u32x4*)(stg+row*64+ch*8); ATTN_STORE16(Ow+(long)row*OP+ch*8,v);} }
  asm volatile("s_waitcnt lgkmcnt(0)\n\ts_barrier":::"memory");
  #undef DMA_K
  #undef DMA_V
  #undef CMASK
  #undef START
  #undef RESC
  #undef ROT
}
constexpr int ATTN_LDS_BYTES=LDS_BYTES;
struct AttnTensors { const bf16* Q; const bf16* K; const bf16* V; bf16* O; };
struct AttnUnit { int h; int qb; };
struct StaticOrder {
  int vcu, G;
  __device__ __forceinline__ explicit StaticOrder(int grid,int block):vcu((grid%8==0)?(block%8)*(grid/8)+block/8:block),G(grid){}
  __device__ __forceinline__ bool next(int i,AttnUnit&u)const{ const int per=(512+G-1)/G; if(i>=per)return false; const int id=vcu*per+i; if(id>=512)return false; u.h=id>>5; u.qb=id&31; return true; }
  __device__ __forceinline__ void a_ready(const AttnUnit&)const{}
  __device__ __forceinline__ void done(const AttnUnit&)const{}
};
template<class Sched,int THRL=8> __device__ __forceinline__ void attn_phase(char*lds,const AttnTensors&T,const Sched&S,int wv){
  AttnUnit u;
  for(int i=0;S.next(i,u);++i){ S.a_ready(u); attn_unit<THRL>(wv,0,u.h,u.qb,T.Q,T.K,T.V,T.O,lds); S.done(u); }
}
#undef SBAR
#undef WAIT_BAR
}


namespace scan {
constexpr int NCH = S / 64;
constexpr int PB = 72, PAB = 68, PRHS = 129;
constexpr int O_RT = 0, O_BT = 9216, O_AT = 18432, O_KT = 27648, O_BTT = 36864, O_KTT = 46080, O_VT = 55296, O_ARB = 64512, O_ARK = 73728, O_AAK = 82944,
              O_AAB = 92160, O_RHS = 109568, O_XT = O_AT  , O_GS = 142592, O_GC = 144640, O_AOFF = 144896, S1_LDS = 154112;
struct Args { const bf16 *R, *V, *KK, *KD0, *KD1, *B0, *B1; const float *LW0, *LW1; bf16 *P, *RP, *Q, *YL, *TT; float *GC; };
typedef float f32x4_t __attribute__((ext_vector_type(4)));
__device__ __forceinline__ f32x4_t mma(bf16x8 a, bf16x8 b, f32x4_t c) { return __builtin_amdgcn_mfma_f32_16x16x32_bf16(a, b, c, 0, 0, 0); }
#define S1_BAR() do { asm volatile("s_waitcnt vmcnt(0) lgkmcnt(0)" ::: "memory"); __builtin_amdgcn_s_barrier(); asm volatile("" ::: "memory"); } while (0)
__device__ __forceinline__ bf16x8 ldfrag(const LAS bf16* m, int row, int k0) { return *(const LAS bf16x8*)(m + row * PB + k0); }

template <class T> __device__ __forceinline__ LAS T* lds_ptr(LAS unsigned char* lds, int off) { unsigned a = (unsigned)(uintptr_t)(lds + off); asm volatile("" : "+v"(a)); return (LAS T*)(uintptr_t)a; }
__device__ __forceinline__ void s1_unit(LAS unsigned char* lds, const Args& A, int d, int h, int c, int wv) {
    int lane_l = lane_id(); asm volatile("" : "+v"(lane_l), "+s"(wv));
    const int lane = lane_l, w = __builtin_amdgcn_readfirstlane(wv), tid = w * 64 + lane, l15 = lane & 15, q = lane >> 4;
    LAS bf16* RT = lds_ptr<bf16>(lds, O_RT); LAS bf16* BT = lds_ptr<bf16>(lds, O_BT); LAS bf16* AT = lds_ptr<bf16>(lds, O_AT); LAS bf16* KT = lds_ptr<bf16>(lds, O_KT);
    LAS bf16* BTT = lds_ptr<bf16>(lds, O_BTT); LAS bf16* KTT = lds_ptr<bf16>(lds, O_KTT); LAS bf16* VT = lds_ptr<bf16>(lds, O_VT);
    LAS bf16* ARB = lds_ptr<bf16>(lds, O_ARB); LAS bf16* ARK = lds_ptr<bf16>(lds, O_ARK); LAS bf16* AAK = lds_ptr<bf16>(lds, O_AAK);
    LAS float* AAB = lds_ptr<float>(lds, O_AAB); LAS float* RHS = lds_ptr<float>(lds, O_RHS); LAS bf16* XT = lds_ptr<bf16>(lds, O_XT);
    LAS float* GS = lds_ptr<float>(lds, O_GS); LAS float* GCL = lds_ptr<float>(lds, O_GC); LAS bf16* AOFF = lds_ptr<bf16>(lds, O_AOFF);
    const bf16* KD = d ? A.KD1 : A.KD0; const bf16* Bg = d ? A.B1 : A.B0; const float* LW = d ? A.LW1 : A.LW0;
    const int u = (d * 16 + h) * NCH + c;
    {
        const int j = lane, ig = w;
        float lwv[8], cumv[8]; unsigned rr[8], kd[8], kk[8], bb[8], vv[8]; float run = 0.f;
#pragma unroll
        for (int k = 0; k < 8; ++k) { const int i = 8 * ig + k, t = d ? (64 * c + 63 - i) : (64 * c + i); const size_t idx = (size_t)t * 1024 + h * 64 + j;
            lwv[k] = LW[idx]; rr[k] = A.R[idx]; kd[k] = KD[idx]; kk[k] = A.KK[idx]; bb[k] = Bg[idx]; vv[k] = A.V[idx]; }
#pragma unroll
        for (int k = 0; k < 8; ++k) { run += lwv[k]; cumv[k] = run; }
        GS[ig * 64 + j] = run;
        S1_BAR();
        float off = 0.f, tot = 0.f;
#pragma unroll
        for (int g = 0; g < 8; ++g) { const float s = GS[g * 64 + j]; off += (g < ig) ? s : 0.f; tot += s; }
        if (ig == 0) GCL[j] = __expf(tot);
        unsigned btT[8], ktT[8];
#pragma unroll
        for (int k = 0; k < 8; ++k) { const int i = 8 * ig + k; const float cum = off + cumv[k];
            const float e1 = __expf(cum), e2 = __expf(-cum), ex = __expf(cum - lwv[k]);
            const float at = -bf2f(kk[k]) * ex, rt = bf2f(rr[k]) * e1, bt = bf2f(bb[k]) * e2, kt = bf2f(kd[k]) * e2;
            RT[i * PB + j] = (bf16)f2bf(rt); AT[i * PB + j] = (bf16)f2bf(at); btT[k] = f2bf(bt); ktT[k] = f2bf(kt);
            BT[i * PB + j] = (bf16)btT[k]; KT[i * PB + j] = (bf16)ktT[k]; RHS[i * PRHS + j] = at; }
        v4u pb, pk, pv;
        pb.x = btT[0] | (btT[1] << 16); pb.y = btT[2] | (btT[3] << 16); pb.z = btT[4] | (btT[5] << 16); pb.w = btT[6] | (btT[7] << 16);
        pk.x = ktT[0] | (ktT[1] << 16); pk.y = ktT[2] | (ktT[3] << 16); pk.z = ktT[4] | (ktT[5] << 16); pk.w = ktT[6] | (ktT[7] << 16);
        pv.x = vv[0] | (vv[1] << 16); pv.y = vv[2] | (vv[3] << 16); pv.z = vv[4] | (vv[5] << 16); pv.w = vv[6] | (vv[7] << 16);
        *(LAS v4u*)(BTT + j * PB + 8 * ig) = pb; *(LAS v4u*)(KTT + j * PB + 8 * ig) = pk; *(LAS v4u*)(VT + j * PB + 8 * ig) = pv;
        S1_BAR();
    }
    {
        const bool isR = w >= 4; const int ibb = w & 3; const LAS bf16* Lm = isR ? RT : AT;
        const bf16x8 a0 = ldfrag(Lm, 16 * ibb + l15, 8 * q), a1 = ldfrag(Lm, 16 * ibb + l15, 8 * q + 32);
#pragma unroll
        for (int sb = 0; sb < 8; ++sb) { const int sbb = sb & 3; const bool isK = sb >= 4;
            f32x4_t acc = (f32x4_t){0.f, 0.f, 0.f, 0.f};
            if (sbb <= ibb) { const LAS bf16* Rm = isK ? KT : BT; acc = mma(a0, ldfrag(Rm, 16 * sbb + l15, 8 * q), acc); acc = mma(a1, ldfrag(Rm, 16 * sbb + l15, 8 * q + 32), acc); }
#pragma unroll
            for (int r = 0; r < 4; ++r) { const int i = 16 * ibb + 4 * q + r, s = 16 * sbb + l15; const bool keep = isR ? (s <= i) : (s < i); const float val = keep ? acc[r] : 0.f;
                if (!isR && !isK) { AAB[i * PAB + s] = val; AOFF[i * PB + s] = (bf16)f2bf(sbb < ibb ? val : 0.f); }
                else { LAS bf16* dst = (!isR) ? AAK : (isK ? ARK : ARB); dst[i * PB + s] = (bf16)f2bf(val); } }
        }
        S1_BAR();
    }
    {
        for (int i = tid; i < 128 * PB * 2 / 16; i += 512) *(LAS v4u*)((LAS unsigned char*)XT + i * 16) = (v4u){0u, 0u, 0u, 0u};
        const int ib = w >> 1;
#pragma unroll
        for (int vbi = 0; vbi < 2; ++vbi) { const int vb = 2 * (w & 1) + vbi; f32x4_t acc = (f32x4_t){0.f, 0.f, 0.f, 0.f};
            acc = mma(ldfrag(AAK, 16 * ib + l15, 8 * q), ldfrag(VT, 16 * vb + l15, 8 * q), acc); acc = mma(ldfrag(AAK, 16 * ib + l15, 8 * q + 32), ldfrag(VT, 16 * vb + l15, 8 * q + 32), acc);
#pragma unroll
            for (int r = 0; r < 4; ++r) RHS[(16 * ib + 4 * q + r) * PRHS + 64 + 16 * vb + l15] = acc[r]; }
        S1_BAR();
    }
    {
#pragma unroll
        for (int b = 0; b < 4; ++b) {
            if (b > 0) {
                f32x4_t acc = (f32x4_t){0.f, 0.f, 0.f, 0.f};
                acc = mma(ldfrag(AOFF, 16 * b + l15, 8 * q), ldfrag(XT, 16 * w + l15, 8 * q), acc);
                if (b == 3) acc = mma(ldfrag(AOFF, 16 * b + l15, 8 * q + 32), ldfrag(XT, 16 * w + l15, 8 * q + 32), acc);
#pragma unroll
                for (int r = 0; r < 4; ++r) RHS[(16 * b + 4 * q + r) * PRHS + 16 * w + l15] += acc[r];
                S1_BAR();
            }
            if (tid < 128) {
                float xb[16];
#pragma unroll
                for (int i = 0; i < 16; ++i) { float sx = RHS[(16 * b + i) * PRHS + tid];
#pragma unroll
                    for (int s4 = 0; s4 < (i + 3) / 4; ++s4) { const f32x4_t av = *(const LAS f32x4_t*)(AAB + (16 * b + i) * PAB + 16 * b + 4 * s4);
#pragma unroll
                        for (int e = 0; e < 4; ++e) if (4 * s4 + e < i) sx += av[e] * xb[4 * s4 + e]; }
                    xb[i] = sx; }
#pragma unroll
                for (int m = 0; m < 2; ++m) { v4u p; p.x = pk2(xb[8 * m], xb[8 * m + 1]); p.y = pk2(xb[8 * m + 2], xb[8 * m + 3]); p.z = pk2(xb[8 * m + 4], xb[8 * m + 5]); p.w = pk2(xb[8 * m + 6], xb[8 * m + 7]);
                    *(LAS v4u*)(XT + tid * PB + 16 * b + 8 * m) = p; }
            }
            S1_BAR();
        }
    }
    {
        const int mat = w >> 1, half = w & 1;
#pragma unroll
        for (int tt = 0; tt < 8; ++tt) { const int tb = 8 * half + tt, rb = tb >> 2, cb = tb & 3;
            f32x4_t acc = (f32x4_t){0.f, 0.f, 0.f, 0.f};
            const LAS bf16* Am = (mat < 2) ? BTT : ARB; const int xrow = ((mat & 1) ? 64 : 0) + 16 * cb + l15;
            acc = mma(ldfrag(Am, 16 * rb + l15, 8 * q), ldfrag(XT, xrow, 8 * q), acc); acc = mma(ldfrag(Am, 16 * rb + l15, 8 * q + 32), ldfrag(XT, xrow, 8 * q + 32), acc);
            if (mat & 1) { const LAS bf16* A2 = (mat == 1) ? KTT : ARK;
                acc = mma(ldfrag(A2, 16 * rb + l15, 8 * q), ldfrag(VT, 16 * cb + l15, 8 * q), acc); acc = mma(ldfrag(A2, 16 * rb + l15, 8 * q + 32), ldfrag(VT, 16 * cb + l15, 8 * q + 32), acc); }
            const int row0 = 16 * rb + 4 * q, col = 16 * cb + l15;
            if (mat == 0) {
#pragma unroll
                for (int r = 0; r < 4; ++r) A.P[(size_t)u * 4096 + (row0 + r) * 64 + col] = (bf16)f2bf(acc[r] * GCL[row0 + r]);
            } else if (mat == 1) {
                uint2 o; o.x = pk2(acc[0] * GCL[row0], acc[1] * GCL[row0 + 1]); o.y = pk2(acc[2] * GCL[row0 + 2], acc[3] * GCL[row0 + 3]);
                *(uint2*)(A.Q + (size_t)u * 4096 + ((cb * 4 + rb) * 64 + lane) * 4) = o;
            } else if (mat == 2) {
#pragma unroll
                for (int r = 0; r < 4; ++r) A.RP[(size_t)u * 4096 + (row0 + r) * 64 + col] = (bf16)f2bf(acc[r] + bf2f(RT[(row0 + r) * PB + col]));
            } else {
                uint2 o; o.x = pk2(acc[0], acc[1]); o.y = pk2(acc[2], acc[3]);
                *(uint2*)(A.YL + (size_t)u * 4096 + ((cb * 4 + rb) * 64 + lane) * 4) = o;
            }
        }
        if (tid < 64) A.GC[(size_t)u * 64 + tid] = GCL[tid];
        S1_BAR();
    }
}
__device__ __forceinline__ void s1_phase(LAS unsigned char* lds, const Args& A, int vcu, int G, int wv) {
    asm volatile("" : "+s"(vcu));
    for (int u = vcu; u < 2 * 16 * NCH; u += G) { const int c = u & (NCH - 1), dh = u >> 7; s1_unit(lds, A, dh >> 4, dh & 15, c, wv); }
}

struct Ops { bf16x8 pf[4][2]; uint2 q[4]; f32x4_t gc[4]; };
__device__ __forceinline__ bf16x8 ld_perm(const bf16* p) { const uint2 lo = *(const uint2*)p, hi = *(const uint2*)(p + 16); const v4u v = {lo.x, lo.y, hi.x, hi.y}; return __builtin_bit_cast(bf16x8, v); }
__device__ __forceinline__ void s2_load(Ops& o, const Args& A, int dh, int vblk, int c, int lane) {
    const int u = dh * NCH + c, l15 = lane & 15, q = lane >> 4;
    const bf16* Pu = A.P + (size_t)u * 4096;
#pragma unroll
    for (int rb = 0; rb < 4; ++rb)
#pragma unroll
        for (int ks = 0; ks < 2; ++ks) o.pf[rb][ks] = ld_perm(Pu + (16 * rb + l15) * 64 + 32 * ks + 4 * q);
#pragma unroll
    for (int rb = 0; rb < 4; ++rb) { o.q[rb] = *(const uint2*)(A.Q + (size_t)u * 4096 + ((vblk * 4 + rb) * 64 + lane) * 4); o.gc[rb] = *(const f32x4_t*)(A.GC + (size_t)u * 64 + 16 * rb + 4 * q); }
}
__device__ __forceinline__ unsigned cvtpk(float lo, float hi) { unsigned r; asm volatile("v_cvt_pk_bf16_f32 %0, %1, %2" : "=v"(r) : "v"(lo), "v"(hi)); return r; }
__device__ __forceinline__ void s2_step(const Ops& o, f32x4_t (&T)[4], const Args& A, int dh, int vblk, int c, int lane) {
    const int u = dh * NCH + c, l15 = lane & 15, q = lane >> 4;
    unsigned tw[4][2];
#pragma unroll
    for (int rb = 0; rb < 4; ++rb) { tw[rb][0] = cvtpk(T[rb][0], T[rb][1]); tw[rb][1] = cvtpk(T[rb][2], T[rb][3]);
        uint2 st; st.x = tw[rb][0]; st.y = tw[rb][1]; *(uint2*)(A.TT + (size_t)u * 4096 + (16 * vblk + l15) * 64 + 16 * rb + 4 * q) = st; }
    bf16x8 tb[2];
#pragma unroll
    for (int ks = 0; ks < 2; ++ks) { const v4u v = {tw[2 * ks][0], tw[2 * ks][1], tw[2 * ks + 1][0], tw[2 * ks + 1][1]}; tb[ks] = __builtin_bit_cast(bf16x8, v); }
#pragma unroll
    for (int rb = 0; rb < 4; ++rb) { const f32x4_t qf = {bf2f(o.q[rb].x & 0xffffu), bf2f(o.q[rb].x >> 16), bf2f(o.q[rb].y & 0xffffu), bf2f(o.q[rb].y >> 16)};
        f32x4_t tn = o.gc[rb] * T[rb] + qf; tn = mma(o.pf[rb][0], tb[0], tn); tn = mma(o.pf[rb][1], tb[1], tn); T[rb] = tn; }
}
__device__ __forceinline__ void s2_phase(const Args& A, int wg, int wave, int lane) {
    asm volatile("" : "+v"(lane), "+s"(wg), "+s"(wave));
    if (wg >= 32 || wave >= 4) return;
    const int dh = wg, d = wg >> 4, vblk = wave;
    f32x4_t T[4];
#pragma unroll
    for (int rb = 0; rb < 4; ++rb) T[rb] = (f32x4_t){0.f, 0.f, 0.f, 0.f};
    Ops oa, ob, oc;
#define CI(k) (d ? NCH - 1 - (k) : (k))
    s2_load(oa, A, dh, vblk, CI(0), lane); s2_load(ob, A, dh, vblk, CI(1), lane);
    int cc = 0;
    for (; cc + 3 <= NCH - 2; cc += 3) {
        s2_load(oc, A, dh, vblk, CI(cc + 2), lane); s2_step(oa, T, A, dh, vblk, CI(cc), lane);
        s2_load(oa, A, dh, vblk, CI(cc + 3), lane); s2_step(ob, T, A, dh, vblk, CI(cc + 1), lane);
        s2_load(ob, A, dh, vblk, CI(cc + 4), lane); s2_step(oc, T, A, dh, vblk, CI(cc + 2), lane);
    }
    s2_step(oa, T, A, dh, vblk, CI(cc), lane); s2_step(ob, T, A, dh, vblk, CI(cc + 1), lane);
#undef CI
}

constexpr int PYS = 65;
__device__ __forceinline__ void s3_post_phase(LAS unsigned char* lds, const Args& A, int vcu, int G, int wv, const bf16* V, const bf16* Gt, const float* BONUS, const float* ln_w, const float* ln_b, bf16* YCAT) {
    int lane_l = lane_id(); asm volatile("" : "+v"(lane_l), "+s"(wv), "+s"(vcu));
    const int lane = lane_l, w = __builtin_amdgcn_readfirstlane(wv), tid = w * 64 + lane, l15 = lane & 15, q = lane >> 4; (void)tid;
    LAS float* YS = (LAS float*)lds;
    for (int un = vcu; un < 16 * NCH; un += G) {
        const int c = un & (NCH - 1), h = un >> 7;
        { const int d = w >> 2, ib = w & 3, u = (d * 16 + h) * NCH + c;
          const bf16* Ru = A.RP + (size_t)u * 4096; const bf16* Tu = A.TT + (size_t)u * 4096;
          const bf16x8 a0 = *(const bf16x8*)(Ru + (16 * ib + l15) * 64 + 8 * q), a1 = *(const bf16x8*)(Ru + (16 * ib + l15) * 64 + 8 * q + 32);
#pragma unroll
          for (int vb = 0; vb < 4; ++vb) {
              const uint2 yl = *(const uint2*)(A.YL + (size_t)u * 4096 + ((vb * 4 + ib) * 64 + lane) * 4);
              f32x4_t acc = {bf2f(yl.x & 0xffffu), bf2f(yl.x >> 16), bf2f(yl.y & 0xffffu), bf2f(yl.y >> 16)};
              acc = mma(a0, *(const bf16x8*)(Tu + (16 * vb + l15) * 64 + 8 * q), acc); acc = mma(a1, *(const bf16x8*)(Tu + (16 * vb + l15) * 64 + 8 * q + 32), acc);
#pragma unroll
              for (int r = 0; r < 4; ++r) { const int i = 16 * ib + 4 * q + r, tok = d ? 63 - i : i; YS[(d * 64 + tok) * PYS + 16 * vb + l15] = acc[r]; }
          } }
        asm volatile("s_waitcnt lgkmcnt(0)" ::: "memory"); __builtin_amdgcn_s_barrier(); asm volatile("" ::: "memory");
#pragma unroll
        for (int k = 0; k < 8; ++k) { const int tok = 8 * w + k, t = 64 * c + tok, ch = h * 64 + lane; const size_t o = (size_t)t * 1024 + ch;
            const float y = YS[tok * PYS + lane] + YS[(64 + tok) * PYS + lane];
            const float mu = wave_sum(y) * (1.f / 64.f); const float dlt = y - mu;
            const float var = wave_sum(dlt * dlt) * (1.f / 64.f);
            float yn = dlt * rsqrtf(var + GN_EPS) * ln_w[ch] + ln_b[ch];
            yn += BONUS[t * 16 + h] * bf2f(V[o]); yn *= bf2f(Gt[o]);
            YCAT[(size_t)t * 2048 + ch] = (bf16)f2bf(yn); }
        asm volatile("s_waitcnt lgkmcnt(0)" ::: "memory"); __builtin_amdgcn_s_barrier(); asm volatile("" ::: "memory");
    }
}
#undef S1_BAR
}

namespace prep {
constexpr int TT = 16, PV = 1032, PS = 72, PG = 168, PD = 40, NGRP = 436;
constexpr int O_RS = 0, O_KS = 33024, O_VS = 66048, O_TW = 99072, O_AD = 103680, O_SG = 108288, O_VD = 113664, O_VP = 114944, PREP_LDS = 131328;
struct Args { const bf16* Z; const float *mu_p, *mu_n, *w0, *a0, *v0, *k_k, *k_a, *r_k; const bf16 *WUPT, *AUPT, *GUPT, *VUPT, *VDNT; const bf16* VFIRST;
              bf16 *R, *V, *KK, *KD0, *KD1, *B0, *B1, *G; float *LW0, *LW1, *BONUS; int layer; };
typedef float pf32x4 __attribute__((ext_vector_type(4)));
__device__ __forceinline__ float fsig(float x) { return __builtin_amdgcn_rcpf(1.0f + __expf(-x)); }
__device__ __forceinline__ void unpack8(const v4u r, float (&f)[8]) {
    f[0] = __builtin_bit_cast(float, r.x << 16); f[1] = __builtin_bit_cast(float, r.x & 0xffff0000u); f[2] = __builtin_bit_cast(float, r.y << 16); f[3] = __builtin_bit_cast(float, r.y & 0xffff0000u);
    f[4] = __builtin_bit_cast(float, r.z << 16); f[5] = __builtin_bit_cast(float, r.z & 0xffff0000u); f[6] = __builtin_bit_cast(float, r.w << 16); f[7] = __builtin_bit_cast(float, r.w & 0xffff0000u);
}
__device__ __forceinline__ pf32x4 mma(bf16x8 a, bf16x8 b, pf32x4 c) { return __builtin_amdgcn_mfma_f32_16x16x32_bf16(a, b, c, 0, 0, 0); }
#define PREP_BAR() do { asm volatile("s_waitcnt vmcnt(0) lgkmcnt(0)" ::: "memory"); __builtin_amdgcn_s_barrier(); asm volatile("" ::: "memory"); } while (0)
__device__ __forceinline__ void tile(LAS unsigned char* lds, const Args& A, int t0, int wv) {
    int lane_l = lane_id(); asm volatile("" : "+v"(lane_l), "+s"(wv));
    const int lane = lane_l, w = __builtin_amdgcn_readfirstlane(wv), tid = w * 64 + lane, l15 = lane & 15, q = lane >> 4;
    LAS bf16* RS = scan::lds_ptr<bf16>(lds, O_RS); LAS bf16* KS = scan::lds_ptr<bf16>(lds, O_KS); LAS bf16* VS = scan::lds_ptr<bf16>(lds, O_VS);
    LAS bf16* TW = scan::lds_ptr<bf16>(lds, O_TW); LAS bf16* AD = scan::lds_ptr<bf16>(lds, O_AD); LAS bf16* SG = scan::lds_ptr<bf16>(lds, O_SG);
    LAS bf16* VD = scan::lds_ptr<bf16>(lds, O_VD); LAS float* VP = scan::lds_ptr<float>(lds, O_VP);
    for (int it = tid; it < TT * NGRP; it += 512) {
        const int tok = it / NGRP, g = it - tok * NGRP, col0 = 8 * g, t = t0 + tok;
        const bf16* zr = A.Z + (size_t)t * ZP + col0;
        const v4u zc = *(const v4u*)zr;
        v4u zp = (v4u){0u, 0u, 0u, 0u}, zn = zp;
        if (t > 0) zp = *(const v4u*)(zr - ZP);
        if (t < S - 1) zn = *(const v4u*)(zr + ZP);
        const f32x4 mp0 = *(const f32x4*)(A.mu_p + col0), mp1 = *(const f32x4*)(A.mu_p + col0 + 4), mn0 = *(const f32x4*)(A.mu_n + col0), mn1 = *(const f32x4*)(A.mu_n + col0 + 4);
        float z[8], p[8], n[8], o[8]; unpack8(zc, z); unpack8(zp, p); unpack8(zn, n);
#pragma unroll
        for (int e = 0; e < 8; ++e) { const float mp = e < 4 ? mp0[e & 3] : mp1[e & 3], mn = e < 4 ? mn0[e & 3] : mn1[e & 3]; o[e] = z[e] + mp * (p[e] - z[e]) + mn * (n[e] - z[e]); }
        LAS bf16* dst;
        if (col0 < 3072) dst = (col0 < 1024 ? RS : (col0 < 2048 ? KS : VS)) + tok * PV + (col0 & 1023);
        else if (col0 < 3200) {
#pragma unroll
            for (int e = 0; e < 8; ++e) o[e] = 2.0f * fsig(2.0f * o[e]) - 1.0f;
            dst = TW + (((col0 - 3072) >> 6) * TT + tok) * PS + ((col0 - 3072) & 63);
        } else if (col0 < 3328) dst = AD + (((col0 - 3200) >> 6) * TT + tok) * PS + ((col0 - 3200) & 63);
        else {
#pragma unroll
            for (int e = 0; e < 8; ++e) o[e] = fsig(o[e]);
            dst = SG + tok * PG + (col0 - 3328);
        }
        v4u pk; pk.x = pk2(o[0], o[1]); pk.y = pk2(o[2], o[3]); pk.z = pk2(o[4], o[5]); pk.w = pk2(o[6], o[7]);
        *(LAS v4u*)dst = pk;
    }
    PREP_BAR();
    if (A.layer > 0) {
        pf32x4 va[2] = {(pf32x4){0.f, 0.f, 0.f, 0.f}, (pf32x4){0.f, 0.f, 0.f, 0.f}};
#pragma unroll
        for (int ks = 0; ks < 4; ++ks) { const bf16x8 a = *(const LAS bf16x8*)(VS + l15 * PV + 128 * w + 32 * ks + 8 * q);
#pragma unroll
            for (int ob = 0; ob < 2; ++ob) va[ob] = mma(a, *(const bf16x8*)(A.VDNT + (size_t)(16 * ob + l15) * 1024 + 128 * w + 32 * ks + 8 * q), va[ob]); }
#pragma unroll
        for (int ob = 0; ob < 2; ++ob)
#pragma unroll
            for (int r = 0; r < 4; ++r) VP[(w * 16 + 4 * q + r) * 32 + 16 * ob + l15] = va[ob][r];
        PREP_BAR();
        { const int tok = tid >> 5, oo = tid & 31; float sacc = 0.f;
#pragma unroll
          for (int k = 0; k < 8; ++k) sacc += VP[(k * 16 + tok) * 32 + oo];
          VD[tok * PD + oo] = (bf16)f2bf(sacc); }
        PREP_BAR();
    }
    bf16x8 tw0[2], tw1[2], ad0[2], ad1[2], sg[5], vdf;
#pragma unroll
    for (int ks = 0; ks < 2; ++ks) { tw0[ks] = *(const LAS bf16x8*)(TW + l15 * PS + 8 * q + 32 * ks); tw1[ks] = *(const LAS bf16x8*)(TW + (TT + l15) * PS + 8 * q + 32 * ks);
        ad0[ks] = *(const LAS bf16x8*)(AD + l15 * PS + 8 * q + 32 * ks); ad1[ks] = *(const LAS bf16x8*)(AD + (TT + l15) * PS + 8 * q + 32 * ks); }
#pragma unroll
    for (int ks = 0; ks < 5; ++ks) sg[ks] = *(const LAS bf16x8*)(SG + l15 * PG + 8 * q + 32 * ks);
    vdf = *(const LAS bf16x8*)(VD + l15 * PD + 8 * q);
    for (int hh = 0; hh < 2; ++hh) {
        const int head = 2 * w + hh;
        float n2[4] = {0.f, 0.f, 0.f, 0.f};
#pragma unroll
        for (int cbb = 0; cbb < 4; ++cbb) { const int c = head * 64 + 16 * cbb + l15; const float kkw = A.k_k[c];
#pragma unroll
            for (int r = 0; r < 4; ++r) { const float kx = bf2f(KS[(4 * q + r) * PV + c]) * kkw; n2[r] += kx * kx; } }
        float inv[4], bon[4] = {0.f, 0.f, 0.f, 0.f};
#pragma unroll
        for (int r = 0; r < 4; ++r) { float v = n2[r]; v += shfl_xor_l(v, lane, 1); v += shfl_xor_l(v, lane, 2); v += shfl_xor_l(v, lane, 4); v += shfl_xor_l(v, lane, 8); inv[r] = 1.0f / fmaxf(sqrtf(v), 1e-12f); }
        for (int cbb = 0; cbb < 4; ++cbb) {
            int c = head * 64 + 16 * cbb + l15; asm volatile("" : "+v"(c));
            pf32x4 aW0 = (pf32x4){0.f, 0.f, 0.f, 0.f}, aW1 = aW0, aA0 = aW0, aA1 = aW0, aG = aW0, aV = aW0;
            { const bf16* wp = A.WUPT + (size_t)c * 64 + 8 * q; const bf16* ap = A.AUPT + (size_t)c * 64 + 8 * q;
#pragma unroll
              for (int ks = 0; ks < 2; ++ks) { aW0 = mma(tw0[ks], *(const bf16x8*)(wp + 32 * ks), aW0); aW1 = mma(tw1[ks], *(const bf16x8*)(wp + 65536 + 32 * ks), aW1);
                  aA0 = mma(ad0[ks], *(const bf16x8*)(ap + 32 * ks), aA0); aA1 = mma(ad1[ks], *(const bf16x8*)(ap + 65536 + 32 * ks), aA1); }
              const bf16* gp = A.GUPT + (size_t)c * 160 + 8 * q;
#pragma unroll
              for (int ks = 0; ks < 5; ++ks) aG = mma(sg[ks], *(const bf16x8*)(gp + 32 * ks), aG);
              if (A.layer > 0) aV = mma(vdf, *(const bf16x8*)(A.VUPT + (size_t)c * 32 + 8 * q), aV); }
            const float w00 = A.w0[c], w01 = A.w0[1024 + c], a00 = A.a0[c], a01 = A.a0[1024 + c], kkw = A.k_k[c], kaw = A.k_a[c], rkw = A.r_k[c];
            const float v0c = A.layer > 0 ? A.v0[c] : 0.f;
#pragma unroll
            for (int r = 0; r < 4; ++r) { const int tok = 4 * q + r; const size_t o = (size_t)(t0 + tok) * 1024 + c;
                const float rr = bf2f(RS[tok * PV + c]), kx = bf2f(KS[tok * PV + c]); float v = bf2f(VS[tok * PV + c]);
                if (A.layer > 0) { const float gate = fsig(aV[r] + v0c); const float vf = bf2f(A.VFIRST[o]); v = v + (vf - v) * gate; }
                const float lw0 = -0.6065306597126334f * fsig(aW0[r] + w00), lw1 = -0.6065306597126334f * fsig(aW1[r] + w01);
                const float a_0 = fsig(aA0[r] + a00), a_1 = fsig(aA1[r] + a01);
                const float kk = kx * kkw * inv[r];
                const float kd0 = kx * (1.f + (a_0 - 1.f) * kaw), kd1 = kx * (1.f + (a_1 - 1.f) * kaw);
                bon[r] += rr * (kd0 + kd1) * rkw;
                A.R[o] = (bf16)f2bf(rr); A.V[o] = (bf16)f2bf(v); A.KK[o] = (bf16)f2bf(kk); A.KD0[o] = (bf16)f2bf(kd0); A.KD1[o] = (bf16)f2bf(kd1);
                A.B0[o] = (bf16)f2bf(kk * a_0); A.B1[o] = (bf16)f2bf(kk * a_1); A.G[o] = (bf16)f2bf(aG[r]); A.LW0[o] = lw0; A.LW1[o] = lw1; }
        }
#pragma unroll
        for (int r = 0; r < 4; ++r) { float v = bon[r]; v += shfl_xor_l(v, lane, 1); v += shfl_xor_l(v, lane, 2); v += shfl_xor_l(v, lane, 4); v += shfl_xor_l(v, lane, 8);
            if (l15 == 0) A.BONUS[(t0 + 4 * q + r) * 16 + head] = v; }
    }
    PREP_BAR();
}
__device__ __forceinline__ void phase(LAS unsigned char* lds, const Args& A, int vcu, int G, int wv) {
    asm volatile("" : "+s"(vcu));
    for (int tl = vcu; tl < S / TT; tl += G) tile(lds, A, tl * TT, wv);
}
#undef PREP_BAR
}


constexpr int NWAVES = 8;
constexpr size_t MiB = 1u << 20;
constexpr size_t WS_CTL = 0, CTL_ZERO_BYTES = 1 * MiB;
constexpr size_t WS_W = 1 * MiB, WL_STRIDE = 122 * MiB;
constexpr size_t OFF_WIN = 0, OFF_WCAT = 36 * MiB, OFF_WO = 44 * MiB, OFF_WXQ = 52 * MiB, OFF_WXO = 54 * MiB, OFF_WGU = 56 * MiB, OFF_WD = 100 * MiB;
constexpr size_t WS_WXKV = WS_W + 4 * WL_STRIDE;
constexpr size_t WS_Z = 505 * MiB;
constexpr size_t WS_HID = WS_Z;
constexpr size_t WS_HB = 649 * MiB;
constexpr size_t WS_MERGED = WS_HB;
constexpr size_t WS_RW = 681 * MiB;
constexpr size_t WS_LW = 825 * MiB;
constexpr size_t WS_YCAT = WS_LW;
constexpr size_t WS_TMP = 889 * MiB;
constexpr size_t WS_YF = WS_TMP;
constexpr size_t WS_QB = 953 * MiB, WS_KB = 969 * MiB, WS_VB = 973 * MiB, WS_XQ = 977 * MiB, WS_XO = 985 * MiB, WS_MKVF = 993 * MiB, WS_MEMN = 1001 * MiB,
                 WS_ROPE = 1005 * MiB, WS_BONUS = 1009 * MiB, WS_S1P = 1010 * MiB, WS_S1R = 1042 * MiB, WS_S1Q = 1074 * MiB, WS_GC = 1106 * MiB, WS_MKVT = 1107 * MiB, WS_WL = 1115 * MiB, WS_END = 1119 * MiB;
constexpr int WLO_WUP = 0, WLO_AUP = 131072, WLO_GUP = 262144, WLO_VUP = 425984, WLO_VDN = 458752, WL_ELEMS = 491520;
constexpr int CW_TMO = 0, CW_CODE = 1, CW_BAR = 4096;
constexpr int RING_OFF = 0, RING_BYTES = 131072, LDS_BYTES = 163840, LDSCTL_OFF = LDS_BYTES - 512, MISC_OFF = LDSCTL_OFF + 320;
static_assert(prep::PREP_LDS <= LDSCTL_OFF && scan::S1_LDS <= LDSCTL_OFF && attn_body::ATTN_LDS_BYTES <= RING_BYTES, "LDS map");

typedef GAS unsigned gu32;
#define RLX_AGENT __ATOMIC_RELAXED, __HIP_MEMORY_SCOPE_AGENT
#define LDS_WAIT() asm volatile("s_waitcnt lgkmcnt(0)" ::: "memory")
#define VM_WAIT() asm volatile("s_waitcnt vmcnt(0)" ::: "memory")

#define XB_TMO      128
#define XB_XCNT(j)  (256  + 64 * (j))
#define XB_XSUB(j)  (1280 + 64 * (j))
#define XB_XGEN(j)  (2304 + 64 * (j))
#define XB_TOP      3328
#define XB_TOPGEN   3392
#define XCD_BAR_WORDS 3456
#define XB_SPIN_CAP (1u << 18)

__device__ __forceinline__ unsigned xb_ld(unsigned* p)              { return __hip_atomic_load(p, __ATOMIC_RELAXED, __HIP_MEMORY_SCOPE_AGENT); }
__device__ __forceinline__ unsigned xb_add(unsigned* p, unsigned v) { return __hip_atomic_fetch_add(p, v, __ATOMIC_RELAXED, __HIP_MEMORY_SCOPE_AGENT); }
__device__ __forceinline__ unsigned xb_xcc_id() { return (unsigned)__builtin_amdgcn_s_getreg((3 << 11) | 20) & 0xFu; }
#define XB_SPIN(cond, bar) do { unsigned _sp = 0; while (cond) { __builtin_amdgcn_s_sleep(1); \
    if ((++_sp & 255u) == 0u) { if (xb_ld(&(bar)[XB_TMO])) break; if (_sp > XB_SPIN_CAP) { atomicAdd(&(bar)[XB_TMO], 1u); break; } } } } while (0)

struct XcdBarrier {
    unsigned* bar; unsigned x; unsigned w;
    volatile LAS unsigned* st;
};

__device__ __forceinline__ XcdBarrier xcd_barrier_post(unsigned* bar, volatile LAS unsigned* st, unsigned wave) {
    XcdBarrier b; b.bar = bar; b.x = xb_xcc_id(); b.st = st; b.w = wave;
    if (wave == 0u && lane_id() == 0) (void)xb_add(&bar[XB_XCNT(b.x)], 1u);
    return b;
}
__device__ __forceinline__ void xcd_barrier_complete(unsigned* bar, unsigned x, unsigned& nloc, unsigned& nx) {
    const unsigned G = gridDim.x * gridDim.y * gridDim.z;
    unsigned sum, cnt, mine, sp = 0u;
    for (;;) {
        sum = 0u; cnt = 0u; mine = 0u;
#pragma unroll
        for (unsigned j = 0; j < 16; ++j) { const unsigned c = xb_ld(&bar[XB_XCNT(j)]); sum += c; cnt += (c > 0u) ? 1u : 0u; mine = (j == x) ? c : mine; }
        if (sum == G) break;
        __builtin_amdgcn_s_sleep(1);
        if ((++sp & 255u) == 0u) { if (xb_ld(&bar[XB_TMO])) break; if (sp > XB_SPIN_CAP) { atomicAdd(&bar[XB_TMO], 1u); break; } }
    }
    nloc = mine > 0u ? mine : 1u; nx = cnt > 0u ? cnt : 1u;
}

__device__ __forceinline__ void xcd_barrier(const XcdBarrier& b) {
    asm volatile("s_waitcnt vmcnt(0)" ::: "memory");
    __syncthreads();
    if (b.w == 0u && lane_id() == 0) {
        unsigned* bar = b.bar;
        __builtin_amdgcn_s_waitcnt(0);
        unsigned nloc = b.st[0], nx = b.st[1];
        if (nloc == 0u) { xcd_barrier_complete(bar, b.x, nloc, nx); b.st[0] = nloc; b.st[1] = nx; }
        const unsigned old = xb_add(&bar[XB_XSUB(b.x)], 1u);
        const unsigned gen = old / nloc;
        if (old + 1u == (gen + 1u) * nloc) {
            __builtin_amdgcn_fence(__ATOMIC_RELEASE, "agent");
            asm volatile("s_waitcnt vmcnt(0)" ::: "memory");
            const unsigned og = xb_add(&bar[XB_TOP], 1u);
            const unsigned tg = og / nx;
            if (og + 1u == (tg + 1u) * nx) xb_add(&bar[XB_TOPGEN], 1u);
            else XB_SPIN(xb_ld(&bar[XB_TOPGEN]) == tg, bar);
            __builtin_amdgcn_fence(__ATOMIC_ACQUIRE, "agent");
            xb_add(&bar[XB_XGEN(b.x)], 1u);
            asm volatile("s_waitcnt vmcnt(0)" ::: "memory");
        } else {
            XB_SPIN(xb_ld(&bar[XB_XGEN(b.x)]) == gen, bar);
            __builtin_amdgcn_fence(__ATOMIC_ACQUIRE, "agent");
            asm volatile("s_waitcnt vmcnt(0)" ::: "memory");
        }
    }
    __syncthreads();
}


#ifndef MK_ONE_LAUNCH
#define MK_ONE_LAUNCH 1
#endif
constexpr int NS = 15;
enum Site { ST_INPROJ = 0, ST_PREP, ST_S1, ST_S2, ST_ATTN, ST_MERGE, ST_WO, ST_NORM1, ST_XQ, ST_XATTN, ST_XO, ST_NORM2, ST_UP, ST_DOWN, ST_NORM3 };
constexpr int NPHASE = 2 + NL * NS;

struct MKArgs { const float* in[36]; float* out; unsigned char* ws; int ph_lo, ph_hi, li, pad; };

struct Frame {
    LAS unsigned char* lds; volatile LAS unsigned* MISC; gu32* ctl;
    int tid, lane, wave, vcu, G;
};

__device__ __forceinline__ void transpose_item(const float* W, int N, bf16* WT, int ldk, int k0, int n0, int drow0, int dk0, LAS float* scr, int lane) {
#pragma unroll 8
    for (int i = 0; i < 32; ++i) { const int kk = 2 * i + (lane >> 5); scr[kk * 33 + (lane & 31)] = W[(size_t)(k0 + kk) * N + n0 + (lane & 31)]; }
    LDS_WAIT(); asm volatile("" ::: "memory");
    const int c = lane & 7;
#pragma unroll
    for (int j = 0; j < 4; ++j) { const int n = (lane >> 3) + 8 * j; const LAS float* s = scr + (8 * c) * 33 + n;
        v4u o; o.x = pk2(s[0 * 33], s[1 * 33]); o.y = pk2(s[2 * 33], s[3 * 33]); o.z = pk2(s[4 * 33], s[5 * 33]); o.w = pk2(s[6 * 33], s[7 * 33]);
        *(GAS v4u*)(WT + (size_t)(drow0 + n) * ldk + dk0 + k0 + 8 * c) = o; }
    LDS_WAIT(); asm volatile("" ::: "memory");
}
__device__ __forceinline__ void rms_row_to_bf16(int lane, const float* xrow, const float* gain, bf16* orow, float* cp) {
    const f32x4* xr = (const f32x4*)xrow + lane;
    f32x4 v[8]; float ss = 0.f;
#pragma unroll
    for (int j = 0; j < 8; ++j) { v[j] = xr[64 * j]; ss += (v[j].x * v[j].x + v[j].y * v[j].y) + (v[j].z * v[j].z + v[j].w * v[j].w); }
    if (cp) {
#pragma unroll
        for (int j = 0; j < 8; ++j) ((f32x4*)cp)[lane + 64 * j] = v[j];
    }
    const float r = rsqrtf(wave_sum(ss) * (1.f / D) + EPS);
    unsigned long long* o8 = (unsigned long long*)orow + lane;
#pragma unroll
    for (int j = 0; j < 8; ++j) { const f32x4 g = ((const f32x4*)gain)[lane + 64 * j];
        o8[64 * j] = (unsigned long long)pk2(v[j].x * r * g.x, v[j].y * r * g.y) | ((unsigned long long)pk2(v[j].z * r * g.z, v[j].w * r * g.w) << 32); }
}

constexpr int I_WIN = 32 * 285, I_RWO = 16 * 64, I_ATO = 16 * 64, I_WO = 32 * 64, I_XQ = 32 * 16, I_XKV = 32 * 32, I_XO = 8 * 64, I_WG = 32 * 176, I_WU = 32 * 176, I_WD = 88 * 64;
constexpr int I_LAYER = I_WIN + I_RWO + I_ATO + I_WO + I_XQ + I_XKV + I_XO + I_WG + I_WU + I_WD;

__device__ __forceinline__ void p0_prologue(Frame& F, const MKArgs& a) {
    LAS float* scr = (LAS float*)(F.lds + RING_OFF + F.wave * 16384);
    unsigned char* ws = a.ws;
    const int gw = F.vcu * NWAVES + F.wave, NGW = F.G * NWAVES;
    for (int it = gw; it < NL * I_LAYER; it += NGW) {
        const int l = it / I_LAYER; int r = it % I_LAYER;
        unsigned char* wl = ws + WS_W + (size_t)l * WL_STRIDE;
        if (r < I_WIN) { const int kb = r / 285, nb = r % 285; transpose_item(a.in[9] + (size_t)l * D * INC, INC, (bf16*)(wl + OFF_WIN), 2048, 64 * kb, 32 * nb, 32 * nb, 0, scr, F.lane); continue; } r -= I_WIN;
        if (r < I_RWO) { const int kb = r / 64, nb = r % 64; transpose_item(a.in[25] + (size_t)l * 1024 * D, D, (bf16*)(wl + OFF_WCAT), 2048, 64 * kb, 32 * nb, 32 * nb, 0, scr, F.lane); continue; } r -= I_RWO;
        if (r < I_ATO) { const int kb = r / 64, nb = r % 64; transpose_item(a.in[28] + (size_t)l * 1024 * D, D, (bf16*)(wl + OFF_WCAT), 2048, 64 * kb, 32 * nb, 32 * nb, 1024, scr, F.lane); continue; } r -= I_ATO;
        if (r < I_WO) { const int kb = r / 64, nb = r % 64; transpose_item(a.in[29] + (size_t)l * D * D, D, (bf16*)(wl + OFF_WO), 2048, 64 * kb, 32 * nb, 32 * nb, 0, scr, F.lane); continue; } r -= I_WO;
        if (r < I_XQ) { const int kb = r / 16, nb = r % 16; transpose_item(a.in[30] + (size_t)l * D * XW, XW, (bf16*)(wl + OFF_WXQ), 2048, 64 * kb, 32 * nb, 32 * nb, 0, scr, F.lane); continue; } r -= I_XQ;
        if (r < I_XKV) { const int kb = r / 32, nb = r % 32; transpose_item(a.in[31] + (size_t)l * D * 1024, 1024, (bf16*)(ws + WS_WXKV), 2048, 64 * kb, 32 * nb, l * 1024 + 32 * nb, 0, scr, F.lane); continue; } r -= I_XKV;
        if (r < I_XO) { const int kb = r / 64, nb = r % 64; transpose_item(a.in[32] + (size_t)l * XW * D, D, (bf16*)(wl + OFF_WXO), 512, 64 * kb, 32 * nb, 32 * nb, 0, scr, F.lane); continue; } r -= I_XO;
        if (r < I_WG) { const int kb = r / 176, nb = r % 176, n0 = 32 * nb; transpose_item(a.in[33] + (size_t)l * D * DFF, DFF, (bf16*)(wl + OFF_WGU), 2048, 64 * kb, n0, 256 * (n0 >> 7) + (n0 & 127), 0, scr, F.lane); continue; } r -= I_WG;
        if (r < I_WU) { const int kb = r / 176, nb = r % 176, n0 = 32 * nb; transpose_item(a.in[34] + (size_t)l * D * DFF, DFF, (bf16*)(wl + OFF_WGU), 2048, 64 * kb, n0, 256 * (n0 >> 7) + 128 + (n0 & 127), 0, scr, F.lane); continue; } r -= I_WU;
        { const int kb = r / 64, nb = r % 64; transpose_item(a.in[35] + (size_t)l * DFF * D, D, (bf16*)(wl + OFF_WD), 5632, 64 * kb, 32 * nb, 32 * nb, 0, scr, F.lane); }
    }
    { const int gt = F.vcu * (NWAVES * 64) + F.tid, NGT = F.G * NWAVES * 64;
      for (int i = gt; i < NL * 96 * 256; i += NGT) { const int l = i / (96 * 256), q = i % (96 * 256);
          *(GAS v4u*)(ws + WS_W + (size_t)l * WL_STRIDE + OFF_WIN + (size_t)9120 * 2048 * 2 + (size_t)q * 16) = (v4u){0u, 0u, 0u, 0u}; }
      float* RC = (float*)(ws + WS_ROPE); float* RS = RC + S * 64;
      for (int i = gt; i < S * 64; i += NGT) { const int t = i >> 6, j = i & 63, f = j & 15;
          const float inv = powf(10000.0f, -(float)f / 16.0f); const float pos = (j < 32) ? (float)(t >> 6) : (float)(t & 63); const float ang = pos * inv;
          RC[i] = cosf(ang); RS[i] = sinf(ang); } }
    { const int gt = F.vcu * (NWAVES * 64) + F.tid, NGT = F.G * NWAVES * 64;
      for (int i = gt; i < NL * WL_ELEMS; i += NGT) { const int l = i / WL_ELEMS, e = i % WL_ELEMS; bf16* dst = (bf16*)(ws + WS_WL) + (size_t)l * WL_ELEMS; float v = 0.f;
          if (e < WLO_AUP) { const int d = e >> 16, c = (e >> 6) & 1023, m = e & 63; v = a.in[13][(((size_t)l * 2 + d) * 64 + m) * 1024 + c]; }
          else if (e < WLO_GUP) { const int r = e - WLO_AUP, d = r >> 16, c = (r >> 6) & 1023, m = r & 63; v = a.in[15][(((size_t)l * 2 + d) * 64 + m) * 1024 + c]; }
          else if (e < WLO_VUP) { const int r = e - WLO_GUP, c = r / 160, m = r % 160; v = a.in[16][((size_t)l * 160 + m) * 1024 + c]; }
          else if (e < WLO_VDN) { const int r = e - WLO_VUP, c = r >> 5, m = r & 31; if (l > 0) v = a.in[19][((size_t)(l - 1) * 32 + m) * 1024 + c]; }
          else { const int r = e - WLO_VDN, o = r >> 10, c = r & 1023; if (l > 0) v = a.in[18][((size_t)(l - 1) * 1024 + c) * 32 + o]; }
          dst[e] = (bf16)f2bf(v); } }
    for (int m = gw; m < NL * NMEM; m += NGW) { const int l = m >> 8, key = m & 255;
        rms_row_to_bf16(F.lane, a.in[1] + (size_t)key * D, a.in[8] + (size_t)l * D, (bf16*)(ws + WS_MEMN) + (size_t)m * D, nullptr); }
    for (int m = gw; m < S; m += NGW) rms_row_to_bf16(F.lane, a.in[0] + (size_t)m * D, a.in[2], (bf16*)(ws + WS_HB) + (size_t)m * D, a.out + (size_t)m * D);
}

__device__ __forceinline__ const float* arg_in(const MKArgs& a, int k) { asm volatile("" : "+s"(k)); return (const float*)(const GAS float*)a.in[k]; }
__device__ __forceinline__ unsigned char* launder(unsigned char* p) { size_t z = 0; asm volatile("" : "+s"(z)); return p + z; }
struct RwPtrs { bf16 *Rb, *Vv, *KKb, *KD0, *KD1, *B0, *B1, *Gb, *VFIRST, *Vcur; float *LW0, *LW1; };
__device__ __forceinline__ RwPtrs rw_ptrs(unsigned char* ws, int l) {
    RwPtrs r; bf16* RWB = (bf16*)(ws + WS_RW); const size_t RWS = (size_t)8 * MiB;
    r.Rb = RWB; r.Vv = RWB + RWS; r.KKb = RWB + 2 * RWS; r.KD0 = RWB + 3 * RWS; r.KD1 = RWB + 4 * RWS; r.B0 = RWB + 5 * RWS; r.B1 = RWB + 6 * RWS; r.Gb = RWB + 7 * RWS; r.VFIRST = RWB + 8 * RWS;
    r.Vcur = (l == 0) ? r.VFIRST : r.Vv; r.LW0 = (float*)(ws + WS_LW); r.LW1 = r.LW0 + (size_t)8 * MiB; return r;
}
__device__ __forceinline__ scan::Args scan_args(unsigned char* ws, int l) {
    const RwPtrs r = rw_ptrs(ws, l);
    return scan::Args{r.Rb, r.Vcur, r.KKb, r.KD0, r.KD1, r.B0, r.B1, r.LW0, r.LW1, (bf16*)(ws + WS_S1P), (bf16*)(ws + WS_S1R), (bf16*)(ws + WS_S1Q), (bf16*)(ws + WS_YF), (bf16*)(ws + WS_YF + 32 * MiB), (float*)(ws + WS_GC)};
}

__global__ void __launch_bounds__(NWAVES * 64, 2) mk_fwd(MKArgs a) {
    extern __shared__ __attribute__((aligned(16))) unsigned char lds[];
    Frame F;
    F.lds = (LAS unsigned char*)lds;
    F.MISC = (volatile LAS unsigned*)(F.lds + MISC_OFF);
    F.wave = __builtin_amdgcn_readfirstlane((int)threadIdx.x >> 6); F.lane = lane_id(); F.tid = F.wave * 64 + F.lane;
    F.G = gridDim.x; { const int bx = blockIdx.x; F.vcu = (F.G % 8 == 0) ? (bx % 8) * (F.G / 8) + bx / 8 : bx; }
    unsigned char* ws = a.ws;
    F.ctl = (gu32*)(ws + WS_CTL);
    for (int u = F.tid; u < (LDS_BYTES - LDSCTL_OFF) / 4; u += NWAVES * 64) ((LAS unsigned*)(F.lds + LDSCTL_OFF))[u] = 0u;
    __syncthreads();
    XcdBarrier bar = xcd_barrier_post((unsigned*)(F.ctl + CW_BAR) + a.li * XCD_BAR_WORDS, F.MISC + 8, (unsigned)F.wave);
    const int lo = a.ph_lo, hi = a.ph_hi;
#ifndef PH_MASK
#define PH_MASK 0xFFFFFFFFu
#endif
#define IN(k) (lo <= (k) && (k) < hi)
#define INS(s) (((PH_MASK >> (s)) & 1u) && IN(pb + (s)))
#define SEAM(k) do { if ((k) + 1 < hi) { XcdBarrier b2_ = bar; { size_t z_ = 0; asm volatile("" : "+s"(z_)); b2_.bar = bar.bar + z_; } xcd_barrier(b2_); } } while (0)

    if (IN(0)) { p0_prologue(F, a); SEAM(0); }
    if (IN(1)) {
        pg8::Gemm g{(const bf16*)(ws + WS_MEMN), (const bf16*)(ws + WS_WXKV), NL * NMEM, NL * 1024, D}; pg8::StaticOrder So; So.init(NL * NMEM, NL * 1024, F.G, (int)blockIdx.x);
        pg8::EpiBf16S E{(bf16*)(ws + WS_MKVF), NL * 1024, 1.f};
        pg8::gemm_phase<pg8::EpiBf16S, pg8::StaticOrder, false, true>(F.lds + RING_OFF, g, So, E, F.wave);
        { pg8::Gemm g2{(const bf16*)(ws + WS_WXKV), (const bf16*)(ws + WS_MEMN), NL * 1024, NL * NMEM, D}; pg8::StaticOrder S2o; S2o.init(NL * 1024, NL * NMEM, F.G, (int)blockIdx.x);
          pg8::EpiBf16S E2{(bf16*)(ws + WS_MKVT), NL * NMEM, 1.f};
          pg8::gemm_phase<pg8::EpiBf16S, pg8::StaticOrder, false, true>(F.lds + RING_OFF, g2, S2o, E2, F.wave); }
        SEAM(1);
    }
    const int gw = F.vcu * NWAVES + F.wave, NGW = F.G * NWAVES;
    for (int l = 0; l < NL; ++l) {
        const int pb = 2 + l * NS;
        if (pb + NS <= lo || pb >= hi) continue;
        if (INS(ST_INPROJ)) {
            unsigned char* ws = launder(a.ws); unsigned char* wl = ws + WS_W + (size_t)l * WL_STRIDE; (void)wl;
            pg8::Gemm g{(const bf16*)(ws + WS_HB), (const bf16*)(wl + OFF_WIN), S, ZP, D}; pg8::StaticOrder So; So.init(S, ZP, F.G, (int)blockIdx.x);
            pg8::EpiBf16S E{(bf16*)(ws + WS_Z), ZP, 1.f};
            pg8::gemm_phase<pg8::EpiBf16S, pg8::StaticOrder, true, true>(F.lds + RING_OFF, g, So, E, F.wave);
            SEAM(pb + ST_INPROJ);
        }
        if (INS(ST_PREP)) {
            unsigned char* ws = launder(a.ws); unsigned char* wl = ws + WS_W + (size_t)l * WL_STRIDE; (void)wl;
            ph_prep_attn(gw, NGW, F.lane, (const bf16*)(ws + WS_Z), arg_in(a, 26) + l * 64, arg_in(a, 27) + l * 64, (const float*)(ws + WS_ROPE), (const float*)(ws + WS_ROPE) + S * 64,
                         (bf16*)(ws + WS_QB), (bf16*)(ws + WS_KB), (bf16*)(ws + WS_VB));
            { const RwPtrs rp = rw_ptrs(ws, l); const int lm = l > 0 ? l - 1 : 0; const bf16* wlo = (const bf16*)(ws + WS_WL) + (size_t)l * WL_ELEMS;
              prep::Args p; p.Z = (const bf16*)(ws + WS_Z); p.mu_p = arg_in(a, 10) + (size_t)l * RWC; p.mu_n = arg_in(a, 11) + (size_t)l * RWC; p.w0 = arg_in(a, 12) + (size_t)l * 2048; p.a0 = arg_in(a, 14) + (size_t)l * 2048;
              p.v0 = arg_in(a, 17) + (size_t)lm * 1024; p.k_k = arg_in(a, 20) + (size_t)l * 1024; p.k_a = arg_in(a, 21) + (size_t)l * 1024; p.r_k = arg_in(a, 22) + (size_t)l * 1024;
              p.WUPT = wlo + WLO_WUP; p.AUPT = wlo + WLO_AUP; p.GUPT = wlo + WLO_GUP; p.VUPT = wlo + WLO_VUP; p.VDNT = wlo + WLO_VDN; p.VFIRST = rp.VFIRST;
              p.R = rp.Rb; p.V = rp.Vcur; p.KK = rp.KKb; p.KD0 = rp.KD0; p.KD1 = rp.KD1; p.B0 = rp.B0; p.B1 = rp.B1; p.G = rp.Gb; p.LW0 = rp.LW0; p.LW1 = rp.LW1; p.BONUS = (float*)(ws + WS_BONUS); p.layer = l;
              __syncthreads();
              prep::phase(F.lds, p, F.vcu, F.G, F.wave); }
            SEAM(pb + ST_PREP);
        }
        if (INS(ST_S1)) { const scan::Args sa = scan_args(launder(a.ws), l); scan::s1_phase(F.lds, sa, F.vcu, F.G, F.wave); SEAM(pb + ST_S1); }
        if (INS(ST_S2)) { const scan::Args sa = scan_args(launder(a.ws), l); scan::s2_phase(sa, (int)blockIdx.x, F.wave, F.lane); SEAM(pb + ST_S2); }
        if (INS(ST_ATTN)) {
            unsigned char* ws = launder(a.ws); unsigned char* wl = ws + WS_W + (size_t)l * WL_STRIDE; (void)wl;
            const scan::Args sa = scan_args(ws, l); const RwPtrs rp = rw_ptrs(ws, l);
            scan::s3_post_phase(F.lds, sa, F.vcu, F.G, F.wave, rp.Vcur, rp.Gb, (const float*)(ws + WS_BONUS), arg_in(a, 23) + (size_t)l * 1024, arg_in(a, 24) + (size_t)l * 1024, (bf16*)(ws + WS_YCAT));
            __syncthreads();
            const attn_body::AttnTensors AT{(const attn_body::bf16*)(ws + WS_QB), (const attn_body::bf16*)(ws + WS_KB), (const attn_body::bf16*)(ws + WS_VB), (attn_body::bf16*)(ws + WS_YCAT) + 1024};
            const attn_body::StaticOrder So((int)F.G, (int)blockIdx.x);
            attn_body::attn_phase<attn_body::StaticOrder>((char*)lds + RING_OFF, AT, So, F.wave);
            SEAM(pb + ST_ATTN);
        }
        if (INS(ST_MERGE)) {
            unsigned char* ws = launder(a.ws); unsigned char* wl = ws + WS_W + (size_t)l * WL_STRIDE; (void)wl;
            pg8::Gemm g{(const bf16*)(ws + WS_YCAT), (const bf16*)(wl + OFF_WCAT), S, D, D}; pg8::StaticOrder So; So.init(S, D, F.G, (int)blockIdx.x);
            pg8::EpiMerge E{(const bf16*)(ws + WS_Z), (bf16*)(ws + WS_MERGED)};
            pg8::gemm_phase<pg8::EpiMerge, pg8::StaticOrder, false, true>(F.lds + RING_OFF, g, So, E, F.wave);
            SEAM(pb + ST_MERGE);
        }
        if (INS(ST_WO)) {
            unsigned char* ws = launder(a.ws); unsigned char* wl = ws + WS_W + (size_t)l * WL_STRIDE; (void)wl;
            pg8::Gemm g{(const bf16*)(ws + WS_MERGED), (const bf16*)(wl + OFF_WO), S, D, D}; pg8::StaticOrder So; So.init(S, D, F.G, (int)blockIdx.x);
            pg8::EpiF32 E{(float*)(ws + WS_TMP), D};
            pg8::gemm_phase<pg8::EpiF32, pg8::StaticOrder, false, true>(F.lds + RING_OFF, g, So, E, F.wave);
            SEAM(pb + ST_WO);
        }
        if (INS(ST_NORM1)) { unsigned char* ws = launder(a.ws); ph_norm(gw, NGW, F.lane, a.out, (const float*)(ws + WS_TMP), arg_in(a, 3) + (size_t)l * D, arg_in(a, 4) + (size_t)l * D, (bf16*)(ws + WS_HB)); SEAM(pb + ST_NORM1); }
        if (INS(ST_XQ)) {
            unsigned char* ws = launder(a.ws); unsigned char* wl = ws + WS_W + (size_t)l * WL_STRIDE; (void)wl;
            pg8::Gemm g{(const bf16*)(ws + WS_HB), (const bf16*)(wl + OFF_WXQ), S, XW, D}; pg8::StaticOrder So; So.init(S, XW, F.G, (int)blockIdx.x);
            pg8::EpiBf16S E{(bf16*)(ws + WS_XQ), XW, XQSCALE};
            pg8::gemm_phase<pg8::EpiBf16S, pg8::StaticOrder, false, true>(F.lds + RING_OFF, g, So, E, F.wave);
            SEAM(pb + ST_XQ);
        }
        if (INS(ST_XATTN)) {
            unsigned char* ws = launder(a.ws); unsigned char* wl = ws + WS_W + (size_t)l * WL_STRIDE; (void)wl;
            ph_xattn(gw, NGW, F.lane, (const bf16*)(ws + WS_XQ), (const bf16*)(ws + WS_MKVF) + (size_t)l * 256 * 4096 + l * 1024, 4096,
                     (const bf16*)(ws + WS_MKVT) + (size_t)(l * 1024 + 512) * 1024 + l * 256, 1024, (bf16*)(ws + WS_XO));
            SEAM(pb + ST_XATTN);
        }
        if (INS(ST_XO)) {
            unsigned char* ws = launder(a.ws); unsigned char* wl = ws + WS_W + (size_t)l * WL_STRIDE; (void)wl;
            pg8::Gemm g{(const bf16*)(ws + WS_XO), (const bf16*)(wl + OFF_WXO), S, D, XW}; pg8::StaticOrder So; So.init(S, D, F.G, (int)blockIdx.x);
            pg8::EpiF32 E{(float*)(ws + WS_TMP), D};
            pg8::gemm_phase<pg8::EpiF32, pg8::StaticOrder, false, true>(F.lds + RING_OFF, g, So, E, F.wave);
            SEAM(pb + ST_XO);
        }
        if (INS(ST_NORM2)) { unsigned char* ws = launder(a.ws); ph_norm(gw, NGW, F.lane, a.out, (const float*)(ws + WS_TMP), arg_in(a, 5) + (size_t)l * D, arg_in(a, 6) + (size_t)l * D, (bf16*)(ws + WS_HB)); SEAM(pb + ST_NORM2); }
        if (INS(ST_UP)) {
            unsigned char* ws = launder(a.ws); unsigned char* wl = ws + WS_W + (size_t)l * WL_STRIDE; (void)wl;
            pg8::Gemm g{(const bf16*)(ws + WS_HB), (const bf16*)(wl + OFF_WGU), S, 2 * DFF, D}; pg8::StaticOrder So; So.init(S, 2 * DFF, F.G, (int)blockIdx.x);
            pg8::EpiSwiGLU E{(bf16*)(ws + WS_HID), DFF};
            pg8::gemm_phase<pg8::EpiSwiGLU, pg8::StaticOrder, true, true>(F.lds + RING_OFF, g, So, E, F.wave);
            SEAM(pb + ST_UP);
        }
        if (INS(ST_DOWN)) {
            unsigned char* ws = launder(a.ws); unsigned char* wl = ws + WS_W + (size_t)l * WL_STRIDE; (void)wl;
            pg8::Gemm g{(const bf16*)(ws + WS_HID), (const bf16*)(wl + OFF_WD), S, D, DFF}; pg8::StaticOrder So; So.init(S, D, F.G, (int)blockIdx.x);
            pg8::EpiF32 E{(float*)(ws + WS_TMP), D};
            pg8::gemm_phase<pg8::EpiF32, pg8::StaticOrder, false, true>(F.lds + RING_OFF, g, So, E, F.wave);
            SEAM(pb + ST_DOWN);
        }
        if (INS(ST_NORM3)) { unsigned char* ws = launder(a.ws); ph_norm(gw, NGW, F.lane, a.out, (const float*)(ws + WS_TMP), arg_in(a, 7) + (size_t)l * D, (l + 1 < NL) ? arg_in(a, 2) + (size_t)(l + 1) * D : (const float*)nullptr, (bf16*)(ws + WS_HB)); SEAM(pb + ST_NORM3); }
    }
#undef IN
#undef INS
#undef SEAM
}

static void mk_launch(hipStream_t st, const MKArgs& base, int lo, int hi, int li = 0) {
    MKArgs a = base; a.ph_lo = lo; a.ph_hi = hi; a.li = li; a.pad = 0;
    hipLaunchKernelGGL(mk_fwd, dim3(256), dim3(NWAVES * 64), LDS_BYTES, st, a);
}

extern "C" void kernel_launch(void* const* d_in, const int* in_sizes, int n_in, void* d_out, int out_size, void* d_ws, size_t ws_size, hipStream_t stream) {
    static int ready = 0;
    if (ready == 0) {
        ready = -1;
        if (n_in != 36 || ws_size < WS_END) { fprintf(stderr, "kernel_launch: unexpected n_in %d / ws_size %zu (need %zu)\n", n_in, ws_size, (size_t)WS_END); return; }
        int dev = 0, cus = 0;
        if (hipGetDevice(&dev) != hipSuccess || hipDeviceGetAttribute(&cus, hipDeviceAttributeMultiprocessorCount, dev) != hipSuccess) return;
        if (cus < 256) { fprintf(stderr, "kernel_launch: %d CUs < 256\n", cus); return; }
        if (hipFuncSetAttribute((const void*)mk_fwd, hipFuncAttributeMaxDynamicSharedMemorySize, LDS_BYTES) != hipSuccess) { fprintf(stderr, "kernel_launch: hipFuncSetAttribute failed\n"); return; }
        int per_cu = 0;
        if (hipOccupancyMaxActiveBlocksPerMultiprocessor(&per_cu, (const void*)mk_fwd, NWAVES * 64, LDS_BYTES) != hipSuccess || per_cu < 1) { fprintf(stderr, "kernel_launch: occupancy query says %d\n", per_cu); }
        (void)hipGetLastError();
        ready = 1;
    }
    if (ready < 0) return;
    unsigned char* ws = (unsigned char*)d_ws;
    (void)hipMemsetAsync(ws + WS_CTL, 0, CTL_ZERO_BYTES, stream);
    MKArgs base{}; for (int i = 0; i < 36; ++i) base.in[i] = (const float*)d_in[i]; base.out = (float*)d_out; base.ws = ws;
#if defined(MK_PROBE_SITE)
    { int done = 0, li = 0;
      for (int l = 0; l < NL; ++l) { const int p = 2 + l * NS + MK_PROBE_SITE; mk_launch(stream, base, done, p + 1, li++); for (int r = 0; r < MK_PROBE_REP; ++r) mk_launch(stream, base, p, p + 1, li++); done = p + 1; }
      mk_launch(stream, base, done, NPHASE, li++); }
#elif MK_ONE_LAUNCH
    mk_launch(stream, base, 0, NPHASE);
#else
    for (int p = 0; p < NPHASE; ++p) mk_launch(stream, base, p, p + 1, p);
#endif
}
```
